# Optimizing an MI355X kernel written in HIP

```python
import math
import jax, jax.numpy as jnp
from jax import lax
import numpy as np

D_MODEL = 1024
BATCH = 16
SEQ = 256
DEPTH = 4
DEC_BATCH = 2
DEC_SEQ = 4096
PAST_LEN = 256

GRID_W = 64
EPS = 1e-6
H_Q = 8
H_KV = 2
HEAD_DIM = 128
ATTN_W = H_Q * HEAD_DIM
KV_W = H_KV * HEAD_DIM
ROPE_THETA = 10000.0
Q_BLOCK = 128
D_INNER = 2 * D_MODEL
SSM_HEAD_DIM = 64
SSM_HEADS = D_INNER // SSM_HEAD_DIM
SSM_GROUPS = 4
SSM_STATE = 128
SSM_CONV = 3
SSM_CHUNK = 128
CONV_CH = D_INNER + 2 * SSM_GROUPS * SSM_STATE
D_FF = 2816
FFN_CONV = 3
IN_SIZES = (ATTN_W, KV_W, KV_W, D_INNER, CONV_CH, 2 * SSM_HEADS, D_MODEL, D_MODEL)
IN_W = ATTN_W + 2 * KV_W + D_INNER + CONV_CH + 2 * SSM_HEADS + 2 * D_MODEL

kernel_name = 'hybrid_dit_gqa_ssd_convffn_step'


def rms_norm(x):
    xf = x.astype(jnp.float32)
    return (xf * lax.rsqrt(jnp.mean(xf * xf, axis=-1, keepdims=True) + EPS)).astype(x.dtype)


def modulate(x, shift, scale):
    return rms_norm(x) * (1.0 + scale) + shift


def dw_conv(x, w, b):
    width = w.shape[0]
    pad = width // 2
    seq = x.shape[1]
    xp = jnp.pad(x, ((0, 0), (pad, width - 1 - pad), (0, 0)))
    out = b
    for i in range(width):
        out = out + xp[:, i:i + seq] * w[i]
    return out


def axial_rope_tables(seq):
    rows = seq // GRID_W
    row = jnp.repeat(jnp.arange(rows), GRID_W).astype(jnp.float32)
    col = jnp.tile(jnp.arange(GRID_W), rows).astype(jnp.float32)
    half = HEAD_DIM // 2
    inv_freq = ROPE_THETA ** (-jnp.arange(0, half, 2, dtype=jnp.float32) / half)
    ang_r = row[:, None] * inv_freq
    ang_c = col[:, None] * inv_freq
    ang = jnp.concatenate([ang_r, ang_r, ang_c, ang_c], axis=-1)
    return jnp.cos(ang), jnp.sin(ang)


def rotate_half(u):
    u1, u2 = jnp.split(u, 2, axis=-1)
    return jnp.concatenate([-u2, u1], axis=-1)


def apply_axial_rope(x, cos, sin):
    xr, xc = jnp.split(x, 2, axis=-1)
    xrot = jnp.concatenate([rotate_half(xr), rotate_half(xc)], axis=-1)
    return (x * cos[None, :, None, :] + xrot * sin[None, :, None, :]).astype(x.dtype)


def block_attention(q, k, v):
    b, lq = q.shape[0], q.shape[1]
    rep = H_Q // H_KV
    nb = lq // Q_BLOCK
    qb = jnp.moveaxis(q.reshape(b, nb, Q_BLOCK, H_KV, rep, HEAD_DIM), 1, 0)
    scale = HEAD_DIM ** -0.5

    def one_block(qi):
        s = jnp.einsum('bqgrd,bkgd->bgrqk', qi, k).astype(jnp.float32) * scale
        p = jax.nn.softmax(s, axis=-1).astype(v.dtype)
        return jnp.einsum('bgrqk,bkgd->bqgrd', p, v)

    o = lax.map(one_block, qb)
    return jnp.moveaxis(o, 0, 1).reshape(b, lq, ATTN_W)


def ssd_scan(x, dt, a, bm, cm, h0):
    b, seq = x.shape[0], x.shape[1]
    nc = seq // SSM_CHUNK
    qc = SSM_CHUNK
    g = SSM_GROUPS
    r = SSM_HEADS // SSM_GROUPS
    f32 = jnp.float32
    x = x.astype(f32).reshape(b, nc, qc, g, r, SSM_HEAD_DIM)
    dt = dt.astype(f32).reshape(b, nc, qc, g, r)
    bm = bm.astype(f32).reshape(b, nc, qc, g, SSM_STATE)
    cm = cm.astype(f32).reshape(b, nc, qc, g, SSM_STATE)
    cum = jnp.cumsum(dt * a.reshape(g, r), axis=2)
    tri = jnp.tril(jnp.ones((qc, qc), dtype=bool))[None, None, :, :, None, None]
    seg = cum[:, :, :, None] - cum[:, :, None]
    decay = jnp.exp(jnp.where(tri, seg, -jnp.inf))
    cb = jnp.einsum('bclgn,bcsgn->bclsg', cm, bm)
    wts = cb[..., None] * decay * dt[:, :, None]
    y_diag = jnp.einsum('bclsgr,bcsgrp->bclgrp', wts, x)
    decay_s = jnp.exp(cum[:, :, -1:] - cum)
    states = jnp.einsum('bcsgn,bcsgrp->bcgrpn', bm, (decay_s * dt)[..., None] * x)
    chunk_decay = jnp.exp(cum[:, :, -1])
    h_init = h0.astype(f32).reshape(b, g, r, SSM_HEAD_DIM, SSM_STATE)

    def step(h, inp):
        dec, st = inp
        return h * dec[..., None, None] + st, h

    h_last, h_prev = lax.scan(step, h_init, (jnp.moveaxis(chunk_decay, 1, 0), jnp.moveaxis(states, 1, 0)))
    h_prev = jnp.moveaxis(h_prev, 0, 1)
    y_off = jnp.einsum('bclgn,bcgrpn->bclgrp', cm, h_prev) * jnp.exp(cum)[..., None]
    y = (y_diag + y_off).reshape(b, seq, SSM_HEADS, SSM_HEAD_DIM)
    return y, h_last.reshape(b, SSM_HEADS, SSM_HEAD_DIM, SSM_STATE)


def ssd_branch(xbc, z, dt_raw, dt_bias, a_log, d_skip, norm_w, init):
    b, seq = xbc.shape[0], xbc.shape[1]
    gn = SSM_GROUPS * SSM_STATE
    xs, bm, cm = jnp.split(xbc, [D_INNER, D_INNER + gn], axis=-1)
    xh = xs.reshape(b, seq, SSM_HEADS, SSM_HEAD_DIM)
    bm = bm.reshape(b, seq, SSM_GROUPS, SSM_STATE)
    cm = cm.reshape(b, seq, SSM_GROUPS, SSM_STATE)
    dt = jax.nn.softplus(dt_raw.astype(jnp.float32).reshape(b, seq, 2, SSM_HEADS) + dt_bias)
    a = -jnp.exp(a_log.astype(jnp.float32))
    y_f, h_f = ssd_scan(xh, dt[:, :, 0], a[0], bm, cm, init[:, 0])
    y_b, h_b = ssd_scan(jnp.flip(xh, 1), jnp.flip(dt[:, :, 1], 1), a[1], jnp.flip(bm, 1), jnp.flip(cm, 1), init[:, 1])
    y = y_f + jnp.flip(y_b, 1) + d_skip[:, None] * xh.astype(jnp.float32)
    y = y.reshape(b, seq, D_INNER) * jax.nn.silu(z.astype(jnp.float32))
    y = rms_norm(y) * norm_w
    return y.astype(xbc.dtype), jnp.stack([h_f, h_b], axis=1).astype(xbc.dtype)


def trunk_layer(x, mod, rope, ctx_k, ctx_v, init_state, p):
    b, seq = x.shape[0], x.shape[1]
    sh1, sc1, g1, sh2, sc2, g2 = jnp.split(mod[:, None, :], 6, axis=-1)
    h = modulate(x, sh1, sc1)
    proj = h @ p['w_in']
    q, k, v, z, xbc, dt_raw, ga, gs = jnp.split(proj, list(np.cumsum(IN_SIZES)[:-1]), axis=-1)
    q = rms_norm(q.reshape(b, seq, H_Q, HEAD_DIM)) * p['q_norm']
    k = rms_norm(k.reshape(b, seq, H_KV, HEAD_DIM)) * p['k_norm']
    v = v.reshape(b, seq, H_KV, HEAD_DIM)
    if rope is None:
        k_all, v_all = k, v
    else:
        cos, sin = rope
        q = apply_axial_rope(q, cos, sin)
        k = apply_axial_rope(k, cos, sin)
        k_all = jnp.concatenate([ctx_k.astype(k.dtype), k], axis=1)
        v_all = jnp.concatenate([ctx_v.astype(v.dtype), v], axis=1)
    attn = block_attention(q, k_all, v_all)
    xbc = jax.nn.silu(dw_conv(xbc, p['conv_w'], p['conv_b']))
    ssd, h_final = ssd_branch(xbc, z, dt_raw, p['dt_bias'], p['a_log'], p['d_skip'], p['ssd_norm'], init_state)
    merged = jax.nn.sigmoid(ga) * (attn @ p['w_attn_o']) + jax.nn.sigmoid(gs) * (ssd @ p['w_ssd_o'])
    x = x + g1 * (merged @ p['w_out'])
    h = modulate(x, sh2, sc2)
    u = dw_conv(h @ p['w_up'], p['ffn_conv_w'], p['ffn_conv_b'])
    u_val, u_gate = jnp.split(u, 2, axis=-1)
    x = x + g2 * ((jax.nn.silu(u_gate) * u_val) @ p['w_down'])
    return x, k, v, h_final


def setup_inputs(seed: int = 0) -> dict:
    key = jax.random.key(seed)
    ks = jax.random.split(key, 26)
    f32 = jnp.float32

    def nrm(k, shape, s):
        return jax.random.normal(k, shape, f32) * s

    dt0 = jnp.exp(jax.random.uniform(ks[14], (DEPTH, 2, SSM_HEADS), f32, math.log(1e-3), math.log(1e-1)))
    return {
        'x_prompt': nrm(ks[0], (BATCH, SEQ, D_MODEL), 1.0),
        'x_sample': nrm(ks[1], (DEC_BATCH, DEC_SEQ, D_MODEL), 1.0),
        'c': nrm(ks[2], (DEC_BATCH, D_MODEL), 1.0),
        'cache_k': nrm(ks[3], (DEC_BATCH, DEPTH, PAST_LEN, H_KV, HEAD_DIM), 1.0),
        'cache_v': nrm(ks[4], (DEC_BATCH, DEPTH, PAST_LEN, H_KV, HEAD_DIM), 1.0),
        'state_ssd': nrm(ks[5], (DEC_BATCH, DEPTH, 2, SSM_HEADS, SSM_HEAD_DIM, SSM_STATE), 0.5),
        'c_ctx': nrm(ks[6], (D_MODEL,), 1.0),
        'w_mod': nrm(ks[7], (DEPTH, D_MODEL, 6 * D_MODEL), D_MODEL ** -0.5),
        'b_mod': nrm(ks[8], (DEPTH, 6 * D_MODEL), 0.01),
        'w_in': nrm(ks[9], (DEPTH, D_MODEL, IN_W), D_MODEL ** -0.5),
        'q_norm': 1.0 + nrm(ks[10], (DEPTH, HEAD_DIM), 0.02),
        'k_norm': 1.0 + nrm(ks[11], (DEPTH, HEAD_DIM), 0.02),
        'conv_w': nrm(ks[12], (DEPTH, SSM_CONV, CONV_CH), SSM_CONV ** -0.5),
        'conv_b': nrm(ks[13], (DEPTH, CONV_CH), 0.01),
        'dt_bias': dt0 + jnp.log(-jnp.expm1(-dt0)),
        'a_log': jnp.log(jax.random.uniform(ks[15], (DEPTH, 2, SSM_HEADS), f32, 1.0, 16.0)),
        'd_skip': 1.0 + nrm(ks[16], (DEPTH, SSM_HEADS), 0.02),
        'ssd_norm': 1.0 + nrm(ks[17], (DEPTH, D_INNER), 0.02),
        'w_attn_o': nrm(ks[18], (DEPTH, ATTN_W, D_MODEL), ATTN_W ** -0.5),
        'w_ssd_o': nrm(ks[19], (DEPTH, D_INNER, D_MODEL), D_INNER ** -0.5),
        'w_out': nrm(ks[20], (DEPTH, D_MODEL, D_MODEL), D_MODEL ** -0.5),
        'w_up': nrm(ks[21], (DEPTH, D_MODEL, 2 * D_FF), D_MODEL ** -0.5),
        'ffn_conv_w': nrm(ks[22], (DEPTH, FFN_CONV, 2 * D_FF), FFN_CONV ** -0.5),
        'ffn_conv_b': nrm(ks[23], (DEPTH, 2 * D_FF), 0.01),
        'w_down': nrm(ks[24], (DEPTH, D_FF, D_MODEL), D_FF ** -0.5),
    }


def reference(x_prompt, x_sample, c, cache_k, cache_v, state_ssd, c_ctx, w_mod, b_mod, w_in, q_norm, k_norm,
              conv_w, conv_b, dt_bias, a_log, d_skip, ssd_norm, w_attn_o, w_ssd_o, w_out, w_up,
              ffn_conv_w, ffn_conv_b, w_down):
    rope = axial_rope_tables(x_sample.shape[1])
    xp = x_prompt
    xs = x_sample
    zero_state = jnp.zeros((xp.shape[0], 2, SSM_HEADS, SSM_HEAD_DIM, SSM_STATE), xp.dtype)
    new_k, new_v, new_s = [], [], []
    for l in range(DEPTH):
        p = {
            'w_in': w_in[l], 'q_norm': q_norm[l], 'k_norm': k_norm[l],
            'conv_w': conv_w[l], 'conv_b': conv_b[l], 'dt_bias': dt_bias[l], 'a_log': a_log[l],
            'd_skip': d_skip[l], 'ssd_norm': ssd_norm[l], 'w_attn_o': w_attn_o[l], 'w_ssd_o': w_ssd_o[l],
            'w_out': w_out[l], 'w_up': w_up[l], 'ffn_conv_w': ffn_conv_w[l], 'ffn_conv_b': ffn_conv_b[l],
            'w_down': w_down[l],
        }
        mod_ctx = jax.nn.silu(c_ctx)[None, :] @ w_mod[l] + b_mod[l]
        mod_lat = jax.nn.silu(c) @ w_mod[l] + b_mod[l]
        xp, k_l, v_l, s_l = trunk_layer(xp, mod_ctx, None, None, None, zero_state, p)
        new_k.append(k_l)
        new_v.append(v_l)
        new_s.append(s_l)
        xs, _, _, _ = trunk_layer(xs, mod_lat, rope, cache_k[:, l], cache_v[:, l], state_ssd[:, l], p)
    new_cache_k = jnp.stack(new_k, axis=1)
    new_cache_v = jnp.stack(new_v, axis=1)
    new_state_ssd = jnp.stack(new_s, axis=1)
    return (xp, xs, new_cache_k, new_cache_v, new_state_ssd)
```

```cpp
#include <hip/hip_runtime.h>
#include <hip/hip_cooperative_groups.h>
#include <cstdint>
#include <cstdio>
namespace cg = cooperative_groups;

#ifndef MK_MULTI
#define MK_MULTI 0
#endif

#ifndef REP_MASK
#define REP_MASK 0
#endif
#define LAS __attribute__((address_space(3)))
typedef unsigned short bf16_t;
typedef short bf16x8 __attribute__((ext_vector_type(8)));
typedef short s16x4 __attribute__((ext_vector_type(4)));
typedef float f32x4 __attribute__((ext_vector_type(4)));
typedef float f32x16 __attribute__((ext_vector_type(16)));
typedef unsigned u32x4 __attribute__((ext_vector_type(4)));
typedef unsigned u32x2 __attribute__((ext_vector_type(2)));

constexpr int DM = 1024, NCTX = 16 * 256, NLAT = 2 * 4096, T = NCTX + NLAT;
constexpr int DEPTH = 4, PAST = 256, LKV = PAST + 4096;
constexpr int INW = 8768, PW = 8704, INWP = 8960;
constexpr int DFF = 2816, UPW = 5632, DIN = 2048, XBCW = 3072;
constexpr int PC_Q = 0, PC_K = 1024, PC_V = 1280, PC_Z = 1536, PC_XBC = 3584, PC_GA = 6656, PC_GS = 7680;
constexpr float EPS = 1e-6f;

constexpr size_t MiB = 1u << 20;
constexpr size_t WS_CTL = 0;
constexpr size_t WS_MOD = 1 * MiB;
constexpr size_t WS_ROPE = 1 * MiB + 512 * 1024;
constexpr size_t WS_W = 2 * MiB;
constexpr size_t W_IN = 0, W_AO = (size_t)INWP * 1024, W_SO = W_AO + 1024 * 1024, W_OUT = W_SO + 1024 * 2048, W_UP = W_OUT + 1024 * 1024, W_DN = W_UP + (size_t)UPW * 1024, W_END = W_DN + (size_t)1024 * DFF;
constexpr size_t WS_WSTRIDE = 43 * MiB;
constexpr size_t WS_P = 88 * MiB;
constexpr size_t WS_H = 294 * MiB;
constexpr size_t WS_Q = 318 * MiB;
constexpr size_t WS_AO = WS_Q;
constexpr size_t WS_K = 342 * MiB;
constexpr size_t WS_V = 349 * MiB;
constexpr size_t WS_XBC = 356 * MiB;
constexpr size_t WS_YF = 428 * MiB;
constexpr size_t WS_YB = 476 * MiB;
constexpr size_t WS_DTR = 524 * MiB;
constexpr size_t WS_DTV = 527 * MiB;
constexpr size_t WS_CUM = 530 * MiB;
constexpr size_t WS_END = 533 * MiB;
static_assert(WS_W + 2 * WS_WSTRIDE <= WS_P, "weight buffers");
static_assert(W_END * 2 <= WS_WSTRIDE, "weights");
constexpr size_t O_X = 0, O_CK = (size_t)T * DM, O_CV = O_CK + (size_t)16 * 4 * 256 * 256, O_ST = O_CV + (size_t)16 * 4 * 256 * 256;

constexpr int LDS_BYTES = 147456;
constexpr int NPH_LAYER = 11, NPH = 1 + DEPTH * NPH_LAYER;

struct Args { const float* in[25]; float* out; unsigned char* ws; int ph_lo, ph_hi, coop, pad; };
enum { I_XP = 0, I_XS, I_C, I_CK, I_CV, I_ST, I_CCTX, I_WMOD, I_BMOD, I_WIN, I_QN, I_KN, I_CONVW, I_CONVB, I_DTB, I_ALOG, I_DSKIP, I_SSDN, I_WAO, I_WSO, I_WOUT, I_WUP, I_FCW, I_FCB, I_WDN };

typedef float f32x2_t __attribute__((ext_vector_type(2))); typedef __bf16 bf16x2_t __attribute__((ext_vector_type(2)));
__device__ __forceinline__ unsigned cvtpk(float lo, float hi) { f32x2_t v = {lo, hi}; bf16x2_t b = __builtin_convertvector(v, bf16x2_t); return __builtin_bit_cast(unsigned, b); }
__device__ __forceinline__ float bf2f(unsigned short b) { return __uint_as_float((unsigned)b << 16); }
__device__ __forceinline__ float bflo(unsigned w) { return __uint_as_float(w << 16); }
__device__ __forceinline__ float bfhi(unsigned w) { return __uint_as_float(w & 0xffff0000u); }
__device__ __forceinline__ void unpack8(u32x4 w, float* f) { f[0] = bflo(w.x); f[1] = bfhi(w.x); f[2] = bflo(w.y); f[3] = bfhi(w.y); f[4] = bflo(w.z); f[5] = bfhi(w.z); f[6] = bflo(w.w); f[7] = bfhi(w.w); }
__device__ __forceinline__ u32x4 pack8(const float* f) { u32x4 w; w.x = cvtpk(f[0], f[1]); w.y = cvtpk(f[2], f[3]); w.z = cvtpk(f[4], f[5]); w.w = cvtpk(f[6], f[7]); return w; }
__device__ __forceinline__ u32x4 zero4() { u32x4 z = {0u, 0u, 0u, 0u}; asm volatile("" : "+v"(z)); return z; }
__device__ __forceinline__ float sigmoidf_(float x) { return __builtin_amdgcn_rcpf(1.f + __expf(-x)); }
__device__ __forceinline__ float siluf_(float x) { return x * __builtin_amdgcn_rcpf(1.f + __expf(-x)); }
__device__ __forceinline__ float wave_sum(float v) {
#pragma unroll
    for (int o = 1; o < 64; o <<= 1) v += __shfl_xor(v, o);
    return v;
}
__device__ __forceinline__ int fresh_tid(int wid) { int ln; asm volatile("v_mbcnt_lo_u32_b32 %0, -1, 0\n\tv_mbcnt_hi_u32_b32 %0, -1, %0" : "=v"(ln)); return wid * 64 + ln; }
__device__ __forceinline__ int mod_idx(int t) { return t < NCTX ? 0 : 1 + ((t - NCTX) >> 12); }

namespace gm {
constexpr int BM = 256, BK = 64, HALF = 128, HTB = HALF * BK * 2, NXCD = 8, WGM = 8;
__device__ __forceinline__ int lds_byte(int r, int c) { const int st = (r >> 4) * 2 + (c >> 5), rr = r & 15, cc = c & 31, ob = rr * 64 + cc * 2; return st * 1024 + (ob ^ (((ob >> 9) & 1) << 5)); }
__device__ __forceinline__ void stage_rc(int b, int& R, int& C) { const int st = b / 1024, sb = b % 1024, swz = sb ^ (((sb >> 9) & 1) << 5); R = (st >> 1) * 16 + swz / 64; C = (st & 1) * 32 + (swz % 64) / 2; }
__device__ __forceinline__ void tile_of(int L, int nM, int nN, int& pm, int& pn) {
    const int nwg = nM * nN; int wgid = L;
    { const int q = nwg / NXCD, r = nwg % NXCD, xcd = wgid % NXCD, off = wgid / NXCD; wgid = (xcd < r ? xcd * (q + 1) : r * (q + 1) + (xcd - r) * q) + off; }
    const int nig = WGM * nN, gid = wgid / nig, fm = gid * WGM, gsz = (nM - fm) < WGM ? (nM - fm) : WGM;
    pm = fm + ((wgid % nig) % gsz); pn = (wgid % nig) / gsz;
}
typedef f32x4 Acc[2][2][4][2];
__device__ __forceinline__ void zero_acc(Acc& acc) {
#pragma unroll
    for (int a = 0; a < 2; ++a)
#pragma unroll
        for (int b = 0; b < 2; ++b)
#pragma unroll
            for (int m = 0; m < 4; ++m)
#pragma unroll
                for (int n = 0; n < 2; ++n) acc[a][b][m][n] = (f32x4){0.f, 0.f, 0.f, 0.f};
}
__device__ __forceinline__ void kloop(LAS unsigned char* lds, int tid, const bf16_t* A, int lda, const bf16_t* Bt, int ldb, int K, Acc& acc) {
    const int wid = __builtin_amdgcn_readfirstlane(tid >> 6), lane = tid & 63, wr = wid >> 2, wc = wid & 3, fr = lane & 15, fq = lane >> 4;
    unsigned voffA[2], voffB[2];
#pragma unroll
    for (int i = 0; i < 2; ++i) { int R, C; stage_rc(tid * 16 + i * 8192, R, C); voffA[i] = (unsigned)(R * lda + C) * 2u; voffB[i] = (unsigned)(R * ldb + C) * 2u; }
    const char* cA = (const char*)A; const char* cB = (const char*)Bt;
    const size_t hA = (size_t)HALF * lda * 2, hB = (size_t)HALF * ldb * 2; const size_t ks = BK * 2;
    const unsigned ldsw = (unsigned)wid * 1024u;
    const int aoff = lds_byte(wr * 64 + fr, fq * 8), boff = lds_byte(wc * 32 + fr, fq * 8);
    const int nt = K / BK;
#define SA_(b, h) (((b) * 2 + (h)) * HTB)
#define SB_(b, h) ((4 + (b) * 2 + (h)) * HTB)
#define STAGE(bufoff, gbase, voff) do { _Pragma("unroll") for (int _i = 0; _i < 2; ++_i) \
        __builtin_amdgcn_global_load_lds((const unsigned*)((const char*)(gbase) + (voff)[_i]), (LAS unsigned*)(lds + (bufoff) + ldsw + _i * 8192), 16, 0, 0); } while (0)
#define LDA(dst, b, h) do { _Pragma("unroll") for (int m = 0; m < 4; ++m) _Pragma("unroll") for (int k = 0; k < 2; ++k) dst[m][k] = *(const LAS bf16x8*)(lds + SA_(b, h) + aoff + m * 2048 + k * 1024); } while (0)
#define LDB(dst, b, h) do { _Pragma("unroll") for (int n = 0; n < 2; ++n) _Pragma("unroll") for (int k = 0; k < 2; ++k) dst[n][k] = *(const LAS bf16x8*)(lds + SB_(b, h) + boff + n * 2048 + k * 1024); } while (0)
#define MMA(ai, bj, At, Bt_) do { __builtin_amdgcn_s_setprio(1); _Pragma("unroll") for (int m = 0; m < 4; ++m) _Pragma("unroll") for (int n = 0; n < 2; ++n) _Pragma("unroll") for (int k = 0; k < 2; ++k) \
        acc[ai][bj][m][n] = __builtin_amdgcn_mfma_f32_16x16x32_bf16(Bt_[n][k], At[m][k], acc[ai][bj][m][n], 0, 0, 0); __builtin_amdgcn_s_setprio(0); } while (0)
#define WAIT_V(n) asm volatile("s_waitcnt vmcnt(" #n ")" ::: "memory")
#define WAIT_L(n) asm volatile("s_waitcnt lgkmcnt(" #n ")" ::: "memory")
#define BAR __builtin_amdgcn_s_barrier()
#define SCHED __builtin_amdgcn_sched_barrier(0)
    bf16x8 At[4][2], B0[2][2], B1[2][2];
    STAGE(SB_(0, 0), cB, voffB); STAGE(SA_(0, 0), cA, voffA); STAGE(SB_(0, 1), cB + hB, voffB); STAGE(SA_(0, 1), cA + hA, voffA);
    if (wr == 1) BAR;
    WAIT_V(4); BAR;
    STAGE(SB_(1, 0), cB + ks, voffB); STAGE(SA_(1, 0), cA + ks, voffA); STAGE(SB_(1, 1), cB + hB + ks, voffB);
    WAIT_V(6); BAR;
    for (int t = 0; t < nt - 2; t += 2) {
        const char* a1 = cA + (size_t)(t + 1) * ks; const char* a2 = cA + (size_t)(t + 2) * ks; const char* b2 = cB + (size_t)(t + 2) * ks;
        const char* a3 = a2 + ks; const char* b3 = b2 + ks;
        LDB(B0, 0, 0); SCHED; LDA(At, 0, 0); STAGE(SA_(1, 1), a1 + hA, voffA);
        WAIT_L(8); BAR; WAIT_L(0); MMA(0, 0, At, B0); BAR; SCHED;
        LDB(B1, 0, 1); STAGE(SB_(0, 0), b2, voffB);
        BAR; WAIT_L(0); MMA(0, 1, At, B1); BAR;
        LDA(At, 0, 1); STAGE(SA_(0, 0), a2, voffA);
        BAR; WAIT_L(0); MMA(1, 0, At, B0); BAR; SCHED;
        STAGE(SB_(0, 1), b2 + hB, voffB);
        WAIT_V(6); BAR; MMA(1, 1, At, B1); BAR;
        LDB(B0, 1, 0); SCHED; LDA(At, 1, 0); STAGE(SA_(0, 1), a2 + hA, voffA);
        WAIT_L(8); BAR; WAIT_L(0); MMA(0, 0, At, B0); BAR; SCHED;
        LDB(B1, 1, 1); STAGE(SB_(1, 0), b3, voffB);
        BAR; WAIT_L(0); MMA(0, 1, At, B1); BAR;
        LDA(At, 1, 1); STAGE(SA_(1, 0), a3, voffA);
        BAR; WAIT_L(0); MMA(1, 0, At, B0); BAR; SCHED;
        STAGE(SB_(1, 1), b3 + hB, voffB);
        WAIT_V(6); BAR; MMA(1, 1, At, B1); BAR;
    }
    { const char* a1 = cA + (size_t)(nt - 1) * ks;
      LDB(B0, 0, 0); LDA(At, 0, 0); STAGE(SA_(1, 1), a1 + hA, voffA);
      BAR; WAIT_L(0); MMA(0, 0, At, B0); BAR;
      LDB(B1, 0, 1); BAR; WAIT_L(0); MMA(0, 1, At, B1); BAR;
      LDA(At, 0, 1); WAIT_V(4); BAR; WAIT_L(0); MMA(1, 0, At, B0); MMA(1, 1, At, B1); BAR; }
    { LDB(B0, 1, 0); LDA(At, 1, 0); WAIT_V(2); BAR; WAIT_L(0); MMA(0, 0, At, B0); BAR;
      LDB(B1, 1, 1); WAIT_V(0); BAR; WAIT_L(0); MMA(0, 1, At, B1); BAR;
      LDA(At, 1, 1); BAR; WAIT_L(0); MMA(1, 0, At, B0); MMA(1, 1, At, B1); BAR; }
    if (wr == 0) BAR;
#undef SA_
#undef SB_
#undef STAGE
#undef LDA
#undef LDB
#undef MMA
#undef WAIT_V
#undef WAIT_L
#undef BAR
#undef SCHED
}
template <class F> __device__ __forceinline__ void for_acc(Acc& acc, int tid, int brow, int bcol, F f) {
    const int wid = tid >> 6, lane = tid & 63, wr = wid >> 2, wc = wid & 3, fr = lane & 15, fq = lane >> 4;
#pragma unroll
    for (int ai = 0; ai < 2; ++ai)
#pragma unroll
        for (int m = 0; m < 4; ++m) {
            const int row = brow + ai * HALF + wr * 64 + m * 16 + fr;
#pragma unroll
            for (int bj = 0; bj < 2; ++bj)
#pragma unroll
                for (int n = 0; n < 2; ++n) f(row, bcol + bj * HALF + wc * 32 + n * 16 + fq * 4, acc[ai][bj][m][n]);
            asm volatile("" ::: "memory");
        }
}
}

namespace at {
constexpr int D = 128, NW = 8, QBLK = 32, KVBLK = 64;
constexpr float SCALE = 0.088388347648318440f, THR = 8.f;
constexpr int LDQ = 1024, LDK = 256, LDO = 1024;
constexpr int SHM_V = KVBLK * D * 2, SHM_K = KVBLK * D * 2, SHM_ATTN = 2 * SHM_V + 2 * SHM_K + NW * 64 * 4;
#define KSWZ(row, colB) ((row) * 256 + ((colB) ^ (((row) & 7) << 4)))
#define SBAR() __builtin_amdgcn_sched_barrier(0)
__device__ __forceinline__ int crow(int r, int hi) { return (r & 3) + 8 * (r >> 2) + 4 * hi; }
__device__ __forceinline__ void partialSM(f32x16& p0, f32x16& p1, float& m_reg, float& mn, float& alpha) {
    constexpr float C = SCALE * 1.4426950408889634f;
    float pmax = p0[0];
#pragma unroll
    for (int r = 1; r < 16; ++r) pmax = fmaxf(pmax, p0[r]);
#pragma unroll
    for (int r = 0; r < 16; ++r) pmax = fmaxf(pmax, p1[r]);
    { auto rr = __builtin_amdgcn_permlane32_swap(__float_as_uint(pmax), __float_as_uint(pmax), false, false);
      pmax = fmaxf(__uint_as_float(rr[0]), __uint_as_float(rr[1])); }
    if (__builtin_expect(__all(pmax - m_reg <= THR / SCALE), 1)) { mn = m_reg; alpha = 1.f; }
    else { mn = fmaxf(m_reg, pmax); alpha = __builtin_amdgcn_exp2f((m_reg - mn) * C); m_reg = mn; }
    float mnC = -mn * C;
#pragma unroll
    for (int r = 0; r < 16; ++r) p0[r] = fmaf(p0[r], C, mnC);
#pragma unroll
    for (int r = 0; r < 16; ++r) p1[r] = fmaf(p1[r], C, mnC);
#pragma unroll
    for (int r = 0; r < 16; ++r) p0[r] = __builtin_amdgcn_exp2f(p0[r]);
}
__device__ __forceinline__ void finishSM(f32x16& p0, f32x16& p1, float alpha, float& l_reg, bf16x8& pa0, bf16x8& pa1, bf16x8& pa2, bf16x8& pa3) {
#pragma unroll
    for (int r = 0; r < 16; ++r) p1[r] = __builtin_amdgcn_exp2f(p1[r]);
    float ps = 0;
#pragma unroll
    for (int r = 0; r < 16; ++r) ps += p0[r];
#pragma unroll
    for (int r = 0; r < 16; ++r) ps += p1[r];
    { auto rr = __builtin_amdgcn_permlane32_swap(__float_as_uint(ps), __float_as_uint(ps), false, false);
      ps = __uint_as_float(rr[0]) + __uint_as_float(rr[1]); }
    l_reg = l_reg * alpha + ps;
#define PK4(P, BASE, OUT) do { unsigned a0 = cvtpk(P[BASE + 0], P[BASE + 1]), a1 = cvtpk(P[BASE + 2], P[BASE + 3]);   \
    unsigned b0 = cvtpk(P[BASE + 4], P[BASE + 5]), b1 = cvtpk(P[BASE + 6], P[BASE + 7]);                              \
    auto r0 = __builtin_amdgcn_permlane32_swap(a0, b0, false, false); auto r1 = __builtin_amdgcn_permlane32_swap(a1, b1, false, false); \
    u32x4 w = {r0[0], r1[0], r0[1], r1[1]}; OUT = *reinterpret_cast<bf16x8*>(&w); } while (0)
    PK4(p0, 0, pa0); PK4(p0, 8, pa1); PK4(p1, 0, pa2); PK4(p1, 8, pa3);
#undef PK4
}
__device__ __forceinline__ void qkt(f32x16& p0, f32x16& p1, const bf16_t* Ks, const bf16x8* qr, int r32, int hi) {
    p0 = f32x16{}; p1 = f32x16{};
#pragma unroll
    for (int d0 = 0; d0 < 8; ++d0) { int cb = (d0 * 16 + hi * 8) * 2;
        bf16x8 b0 = *reinterpret_cast<const bf16x8*>((const char*)Ks + KSWZ(r32, cb));
        bf16x8 b1 = *reinterpret_cast<const bf16x8*>((const char*)Ks + KSWZ(32 + r32, cb));
        p0 = __builtin_amdgcn_mfma_f32_32x32x16_bf16(b0, qr[d0], p0, 0, 0, 0);
        p1 = __builtin_amdgcn_mfma_f32_32x32x16_bf16(b1, qr[d0], p1, 0, 0, 0); }
}
__device__ __forceinline__ int v_st(int k, int c) { const int kk = (k & ~0xC) | ((k & 4) << 1) | ((k & 8) >> 1); return ((kk >> 3) * 4 + (c >> 5)) * 512 + ((kk & 7) * 32 + (c & 31)) * 2; }
__device__ __forceinline__ int v_rd_base(int lane) { return ((lane & 3) << 3) | (((lane >> 2) & 3) << 6) | (((lane >> 4) & 1) << 5) | (((lane >> 5) & 1) << 8); }
constexpr int v_rd_off(int d0, int ks, int half) { return d0 * 512 + ks * 4096 + half * 2048; }
template <int OFF> __device__ __forceinline__ s16x4 tr_read(int vb) {
    s16x4 r; asm volatile("ds_read_b64_tr_b16 %0, %1 offset:%2" : "=&v"(r) : "v"(vb), "i"(OFF) : "memory"); return r;
}
template <int D0> __device__ __forceinline__ void pv_one(f32x16& od, int vb, bf16x8 pa0, bf16x8 pa1, bf16x8 pa2, bf16x8 pa3) {
    const s16x4 l0 = tr_read<v_rd_off(D0, 0, 0)>(vb), h0 = tr_read<v_rd_off(D0, 0, 1)>(vb), l1 = tr_read<v_rd_off(D0, 1, 0)>(vb), h1 = tr_read<v_rd_off(D0, 1, 1)>(vb);
    const s16x4 l2 = tr_read<v_rd_off(D0, 2, 0)>(vb), h2 = tr_read<v_rd_off(D0, 2, 1)>(vb), l3 = tr_read<v_rd_off(D0, 3, 0)>(vb), h3 = tr_read<v_rd_off(D0, 3, 1)>(vb);
    asm volatile("s_waitcnt lgkmcnt(0)" ::: "memory"); SBAR();
#define PK(L, H) (bf16x8){L[0], L[1], L[2], L[3], H[0], H[1], H[2], H[3]}
    od = __builtin_amdgcn_mfma_f32_32x32x16_bf16(pa0, PK(l0, h0), od, 0, 0, 0);
    od = __builtin_amdgcn_mfma_f32_32x32x16_bf16(pa1, PK(l1, h1), od, 0, 0, 0);
    od = __builtin_amdgcn_mfma_f32_32x32x16_bf16(pa2, PK(l2, h2), od, 0, 0, 0);
    od = __builtin_amdgcn_mfma_f32_32x32x16_bf16(pa3, PK(l3, h3), od, 0, 0, 0);
#undef PK
}
__device__ __forceinline__ void pv_d0(f32x16* o, int vb, bf16x8 pa0, bf16x8 pa1, bf16x8 pa2, bf16x8 pa3) {
    pv_one<0>(o[0], vb, pa0, pa1, pa2, pa3); pv_one<1>(o[1], vb, pa0, pa1, pa2, pa3); pv_one<2>(o[2], vb, pa0, pa1, pa2, pa3); pv_one<3>(o[3], vb, pa0, pa1, pa2, pa3);
}
__device__ __forceinline__ void attn_body(const bf16_t* __restrict__ Qb, const bf16_t* __restrict__ Kh, const bf16_t* __restrict__ Vh, bf16_t* __restrict__ Ob, int seq, char* lds, int tid) {
    const int wid = tid >> 6, lane = tid & 63, r32 = lane & 31, hi = lane >> 5;
    bf16_t* V_lds = (bf16_t*)lds; bf16_t* K_lds = (bf16_t*)(lds + 2 * SHM_V);
    float* ws = (float*)(lds + 2 * SHM_V + 2 * SHM_K) + wid * 64; float* li_l = ws; float* al_l = ws + 32;
    float m_reg = -1e30f, l_reg = 0; f32x16 o[4] = {}; bf16x8 qr[8];
    const bf16_t* Qw = Qb + (long)(wid * QBLK + r32) * LDQ + hi * 8;
#pragma unroll
    for (int d0 = 0; d0 < 8; ++d0) qr[d0] = *reinterpret_cast<const bf16x8*>(Qw + d0 * 16);
    const int sr = tid >> 4, sc = (tid & 15) * 8, vst0 = v_st(sr, sc), vst1 = v_st(32 + sr, sc);
    const int vb0 = (int)(uintptr_t)V_lds + v_rd_base(lane);
    struct { bf16x8 vs0, vs1, ks0, ks1; } sr_[2];
#define SLOAD(i, k0) do { sr_[i].vs0 = *(const bf16x8*)(&Vh[(long)((k0) + sr) * LDK + sc]); sr_[i].vs1 = *(const bf16x8*)(&Vh[(long)((k0) + 32 + sr) * LDK + sc]); \
    sr_[i].ks0 = *(const bf16x8*)(&Kh[(long)((k0) + sr) * LDK + sc]); sr_[i].ks1 = *(const bf16x8*)(&Kh[(long)((k0) + 32 + sr) * LDK + sc]); } while (0)
#define SWRITE(b, i) do { *(bf16x8*)((char*)V_lds + (b) * SHM_V + vst0) = sr_[i].vs0;          \
    *(bf16x8*)((char*)V_lds + (b) * SHM_V + vst1) = sr_[i].vs1; int kc = sc * 2;               \
    *(bf16x8*)((char*)K_lds + (b) * SHM_K + KSWZ(sr, kc)) = sr_[i].ks0;                       \
    *(bf16x8*)((char*)K_lds + (b) * SHM_K + KSWZ(32 + sr, kc)) = sr_[i].ks1; } while (0)
#define SWAIT() asm volatile("s_waitcnt vmcnt(4)" ::: "memory")
#define RESC(a) do { if (__any((a) < 1.f)) { if (hi == 0) al_l[r32] = (a); asm volatile("s_waitcnt lgkmcnt(0)" ::: "memory"); \
    _Pragma("unroll") for (int d = 0; d < 4; ++d) _Pragma("unroll") for (int r = 0; r < 16; ++r) o[d][r] *= al_l[crow(r, hi)]; } } while (0)
    f32x16 pA0, pA1, pB0, pB1; float mnA, mnB, alA, alB; bf16x8 pa0, pa1, pa2, pa3; const int NT = seq / KVBLK;
    constexpr int SE = 0, SO = 1;
    SLOAD(SE, 0); asm volatile("s_waitcnt vmcnt(0)" ::: "memory"); SWRITE(0, SE); __syncthreads();
    qkt(pA0, pA1, K_lds, qr, r32, hi); partialSM(pA0, pA1, m_reg, mnA, alA);
    SLOAD(SO, KVBLK); if (2 < NT) SLOAD(SE, 2 * KVBLK);
    SWAIT(); SWRITE(1, SO); __syncthreads();
    for (int j = 1; j + 1 < NT; j += 2) {
        SBAR(); qkt(pB0, pB1, (bf16_t*)((char*)K_lds + SHM_K), qr, r32, hi);
        finishSM(pA0, pA1, alA, l_reg, pa0, pa1, pa2, pa3); SBAR();
        SLOAD(SO, (j + 2) * KVBLK); SBAR();
        pv_d0(o, vb0, pa0, pa1, pa2, pa3); partialSM(pB0, pB1, m_reg, mnB, alB);
        __syncthreads(); SWAIT(); SWRITE(0, SE);
        RESC(alB); __syncthreads();
        SBAR(); qkt(pA0, pA1, K_lds, qr, r32, hi);
        finishSM(pB0, pB1, alB, l_reg, pa0, pa1, pa2, pa3); SBAR();
        if (j + 3 < NT) SLOAD(SE, (j + 3) * KVBLK); SBAR();
        pv_d0(o, vb0 + (int)SHM_V, pa0, pa1, pa2, pa3); partialSM(pA0, pA1, m_reg, mnA, alA);
        __syncthreads(); SWAIT(); SWRITE(1, SO);
        RESC(alA); __syncthreads();
    }
    SBAR(); qkt(pB0, pB1, (bf16_t*)((char*)K_lds + SHM_K), qr, r32, hi);
    finishSM(pA0, pA1, alA, l_reg, pa0, pa1, pa2, pa3); SBAR();
    pv_d0(o, vb0, pa0, pa1, pa2, pa3); partialSM(pB0, pB1, m_reg, mnB, alB);
    __syncthreads(); RESC(alB);
    finishSM(pB0, pB1, alB, l_reg, pa0, pa1, pa2, pa3); SBAR();
    pv_d0(o, vb0 + (int)SHM_V, pa0, pa1, pa2, pa3);
    if (hi == 0) li_l[r32] = l_reg; asm volatile("s_waitcnt lgkmcnt(0)" ::: "memory");
    float rli[16];
#pragma unroll
    for (int r = 0; r < 16; ++r) rli[r] = __builtin_amdgcn_rcpf(li_l[crow(r, hi)]);
    bf16_t* Ow = Ob + (long)(wid * QBLK) * LDO;
#pragma unroll
    for (int r = 0; r < 16; ++r) { int orow = crow(r, hi);
#pragma unroll
        for (int d0 = 0; d0 < 4; ++d0) Ow[(long)orow * LDO + d0 * 32 + r32] = (bf16_t)(cvtpk(o[d0][r] * rli[r], 0.f) & 0xffffu); }
    __syncthreads();
#undef SLOAD
#undef SWRITE
#undef SWAIT
#undef RESC
}
#undef KSWZ
#undef SBAR
}

typedef __attribute__((address_space(4))) const Args CArgs;
typedef CArgs* ArgsP;
struct Ctx {
    ArgsP a; LAS unsigned char* lds; char* ldsg; int tid, lane, wid, gw, ngw;
};

__device__ __forceinline__ unsigned f2bf(float f) { unsigned u = __float_as_uint(f); return (u + 0x7fffu + ((u >> 16) & 1u)) >> 16; }
__device__ __forceinline__ unsigned pk2(float lo, float hi) { return f2bf(lo) | (f2bf(hi) << 16); }
__device__ __forceinline__ void transpose_item(const float* W, int K, int N, bf16_t* WT, LAS float* scr, int item, int lane, bool remap) {
    const int nblk = N / 32, kb = item / nblk, nb = item % nblk, k0 = 64 * kb, n0 = 32 * nb;
    int r0 = n0;
    if (remap) r0 = (n0 < 6656) ? n0 : (n0 < 6720 ? n0 - 6656 + 8704 : n0 - 64);
    float tv[32];
#pragma unroll
    for (int i = 0; i < 32; ++i) { const int kk = 2 * i + (lane >> 5); tv[i] = W[(size_t)(k0 + kk) * N + n0 + (lane & 31)]; }
#pragma unroll
    for (int i = 0; i < 32; ++i) { const int kk = 2 * i + (lane >> 5); scr[kk * 33 + (lane & 31)] = tv[i]; }
    asm volatile("s_waitcnt lgkmcnt(0)" ::: "memory");
    const int c = lane & 7;
#pragma unroll
    for (int j = 0; j < 4; ++j) { const int n = (lane >> 3) + 8 * j; const LAS float* s = scr + (8 * c) * 33 + n;
        u32x4 o; o.x = pk2(s[0 * 33], s[1 * 33]); o.y = pk2(s[2 * 33], s[3 * 33]); o.z = pk2(s[4 * 33], s[5 * 33]); o.w = pk2(s[6 * 33], s[7 * 33]);
        *(u32x4*)(WT + (size_t)(r0 + n) * K + k0 + 8 * c) = o; }
    asm volatile("s_waitcnt lgkmcnt(0)" ::: "memory");
}
__device__ __forceinline__ void convert_weights(const Ctx& c, int l, int gw, int ngw) {
    CArgs& a = *c.a; bf16_t* W = (bf16_t*)(a.ws + WS_W + (size_t)(l & 1) * WS_WSTRIDE);
    LAS float* scr = (LAS float*)(c.lds + c.wid * 16384);
    constexpr int I_IN = 16 * (INW / 32), I_AO = 16 * 32, I_SO = 32 * 32, I_OUT = 16 * 32, I_UP = 16 * (UPW / 32), I_DN = (DFF / 64) * 32;
    constexpr int NIT = I_IN + I_AO + I_SO + I_OUT + I_UP + I_DN;
    for (int it = gw; it < NIT; it += ngw) {
        int r = it;
        if (r < I_IN) { transpose_item(a.in[I_WIN] + (size_t)l * 1024 * INW, 1024, INW, W + W_IN, scr, r, c.lane, true); continue; } r -= I_IN;
        if (r < I_AO) { transpose_item(a.in[I_WAO] + (size_t)l * 1024 * 1024, 1024, 1024, W + W_AO, scr, r, c.lane, false); continue; } r -= I_AO;
        if (r < I_SO) { transpose_item(a.in[I_WSO] + (size_t)l * 2048 * 1024, 2048, 1024, W + W_SO, scr, r, c.lane, false); continue; } r -= I_SO;
        if (r < I_OUT) { transpose_item(a.in[I_WOUT] + (size_t)l * 1024 * 1024, 1024, 1024, W + W_OUT, scr, r, c.lane, false); continue; } r -= I_OUT;
        if (r < I_UP) { transpose_item(a.in[I_WUP] + (size_t)l * 1024 * UPW, 1024, UPW, W + W_UP, scr, r, c.lane, false); continue; } r -= I_UP;
        transpose_item(a.in[I_WDN] + (size_t)l * DFF * 1024, DFF, 1024, W + W_DN, scr, r, c.lane, false);
    }
    for (int i = gw * 64 + c.lane; i < 192 * 1024 / 8; i += ngw * 64) *(u32x4*)(W + W_IN + (size_t)8768 * 1024 + (size_t)i * 8) = zero4();
}

__device__ __forceinline__ void modulate_phase(const Ctx& c, int l, int which) {
    CArgs& a = *c.a; const float* x = a.out + O_X; bf16_t* H = (bf16_t*)(a.ws + WS_H);
    const float* modl = (const float*)(a.ws + WS_MOD) + (size_t)l * 3 * 6144;
    for (int t = c.gw; t < T; t += c.ngw) {
        const float* md = modl + mod_idx(t) * 6144 + which * 3072; const float* sh = md; const float* sc = md + 1024;
        const f32x4* xr = (const f32x4*)(x + (size_t)t * DM);
        f32x4 v[4]; float s = 0.f;
#pragma unroll
        for (int j = 0; j < 4; ++j) { v[j] = xr[c.lane + 64 * j]; s += v[j].x * v[j].x + v[j].y * v[j].y + v[j].z * v[j].z + v[j].w * v[j].w; }
        const float rstd = rsqrtf(wave_sum(s) * (1.f / DM) + EPS);
#pragma unroll
        for (int j = 0; j < 4; ++j) { const int col = (c.lane + 64 * j) * 4; const f32x4 scv = *(const f32x4*)(sc + col), shv = *(const f32x4*)(sh + col);
            const f32x4 o = v[j] * rstd * (scv + 1.f) + shv; u32x2 w; w.x = cvtpk(o.x, o.y); w.y = cvtpk(o.z, o.w);
            *(u32x2*)(H + (size_t)t * DM + col) = w; }
    }
}

__device__ __forceinline__ void setup_phase(const Ctx& c) {
    CArgs& a = *c.a;
    { const int g = blockIdx.x * 512 + c.tid;
      if (g < 2048) { const int pos = g >> 5, i = g & 31; const float inv = __builtin_amdgcn_exp2f(-(float)i * (13.287712379549449f / 32.0f)); const float ang = (float)pos * inv;
          float* rt = (float*)(a.ws + WS_ROPE); rt[g] = __cosf(ang); rt[2048 + g] = __sinf(ang); } }
    LAS float* sl = (LAS float*)c.lds; LAS float* red = (LAS float*)(c.lds + 12288);
    for (int i = c.tid; i < 3072; i += 512) { const int s = i >> 10, k = i & 1023; const float cv = s == 0 ? a.in[I_CCTX][k] : a.in[I_C][(s - 1) * 1024 + k]; sl[i] = siluf_(cv); }
    __syncthreads();
    float* mod = (float*)(a.ws + WS_MOD);
    for (int item = blockIdx.x; item < 192; item += gridDim.x) {
        const int l = item / 48, cb = (item % 48) >> 1, kh = item & 1, col = cb * 256 + c.lane * 4, k0 = kh * 512 + c.wid * 64;
        f32x4 acc[3] = {{0.f, 0.f, 0.f, 0.f}, {0.f, 0.f, 0.f, 0.f}, {0.f, 0.f, 0.f, 0.f}};
        const float* wp = a.in[I_WMOD] + ((size_t)l * 1024 + k0) * 6144 + col;
#pragma unroll 16
        for (int k = 0; k < 64; ++k) { const f32x4 w = *(const f32x4*)(wp + (size_t)k * 6144);
            acc[0] += w * sl[k0 + k]; acc[1] += w * sl[1024 + k0 + k]; acc[2] += w * sl[2048 + k0 + k]; }
#pragma unroll
        for (int s = 0; s < 3; ++s) *(LAS f32x4*)(red + (c.wid * 3 + s) * 256 + c.lane * 4) = acc[s];
        __syncthreads();
        for (int e = c.tid; e < 768; e += 512) { const int s = e >> 8, cc = e & 255; float v = kh == 0 ? a.in[I_BMOD][(size_t)l * 6144 + cb * 256 + cc] : 0.f;
#pragma unroll
            for (int w = 0; w < 8; ++w) v += red[(w * 3 + s) * 256 + cc];
            atomicAdd(&mod[((size_t)l * 3 + s) * 6144 + cb * 256 + cc], v); }
        __syncthreads();
    }
    { const f32x4* xp = (const f32x4*)a.in[I_XP]; const f32x4* xs = (const f32x4*)a.in[I_XS]; f32x4* o = (f32x4*)(a.out + O_X);
      const size_t n1 = (size_t)NCTX * DM / 4, n = (size_t)T * DM / 4, st = (size_t)gridDim.x * 512;
      for (size_t i = (size_t)blockIdx.x * 512 + c.tid; i < n; i += 4 * st) {
          f32x4 v[4];
#pragma unroll
          for (int u = 0; u < 4; ++u) { const size_t j = i + u * st; if (j < n) v[u] = j < n1 ? xp[j] : xs[j - n1]; }
#pragma unroll
          for (int u = 0; u < 4; ++u) { const size_t j = i + u * st; if (j < n) o[j] = v[u]; } } }
    convert_weights(c, 0, c.gw, c.ngw);
}

__device__ __forceinline__ void e2_phase(const Ctx& c, int l) {
    CArgs& a = *c.a;
    const bf16_t* P = (const bf16_t*)(a.ws + WS_P); bf16_t* Q = (bf16_t*)(a.ws + WS_Q); bf16_t* KB = (bf16_t*)(a.ws + WS_K); bf16_t* VB = (bf16_t*)(a.ws + WS_V);
    bf16_t* XB = (bf16_t*)(a.ws + WS_XBC);
    const float* rt = (const float*)(a.ws + WS_ROPE);
    const int lane = c.lane;
    constexpr int NT_DT = 96 * 16, NT_CACHE = 512, NRUN = T / 32, NT_TOK = NRUN * 9;
    for (int id = c.gw; id < NT_DT + NT_CACHE + NT_TOK; id += c.ngw) {
        if (id < NT_DT) {
            const int chk = id >> 4, col = (id & 15) * 4 + (lane >> 4), rg = lane & 15, dir = col >> 5, row0 = chk * 128;
            const float bias = a.in[I_DTB][l * 64 + col], av = -__expf(a.in[I_ALOG][l * 64 + col]);
            const float* dr = (const float*)(a.ws + WS_DTR); float* dv = (float*)(a.ws + WS_DTV); float* cm = (float*)(a.ws + WS_CUM);
            float d[8], cs[8];
#pragma unroll
            for (int e = 0; e < 8; ++e) { const int i = rg * 8 + e, row = row0 + (dir ? 127 - i : i); d[e] = dr[(size_t)row * 64 + col] + bias; }
            float run = 0.f;
#pragma unroll
            for (int e = 0; e < 8; ++e) { const float xr = d[e]; d[e] = xr > 20.f ? xr : log1pf(__expf(xr)); run += d[e] * av; cs[e] = run; }
            float inc = run;
#pragma unroll
            for (int o = 1; o < 16; o <<= 1) { const float t = __shfl_up(inc, o, 16); if (rg >= o) inc += t; }
            const float off = inc - run;
#pragma unroll
            for (int e = 0; e < 8; ++e) { const int i = rg * 8 + e, row = row0 + (dir ? 127 - i : i); dv[(size_t)row * 64 + col] = d[e]; cm[(size_t)row * 64 + col] = cs[e] + off; }
            continue;
        }
        if (id < NT_DT + NT_CACHE) {
            const int r = id - NT_DT, b = r >> 8, j = r & 255; const bool isv = lane >= 32; const int li = lane & 31;
            const float* src = a.in[isv ? I_CV : I_CK] + (((size_t)b * DEPTH + l) * PAST + j) * 256 + li * 8;
            const f32x4 v0 = *(const f32x4*)src, v1 = *(const f32x4*)(src + 4);
            u32x4 w; w.x = cvtpk(v0.x, v0.y); w.y = cvtpk(v0.z, v0.w); w.z = cvtpk(v1.x, v1.y); w.w = cvtpk(v1.z, v1.w);
            *(u32x4*)((isv ? VB : KB) + (size_t)(NCTX + b * LKV + j) * 256 + li * 8) = w;
            continue;
        }
        const int id2 = id - NT_DT - NT_CACHE;
        if (id2 < NRUN * 6) {
            const int run = id2 / 6, wt = id2 % 6, t0 = run * 32, c0 = (wt * 64 + lane) * 8;
            const bool lat = t0 >= NCTX; const int tt = lat ? t0 - NCTX : t0; const int pos0 = lat ? tt & 4095 : tt & 255, L = lat ? 4096 : 256;
            const float* cw = a.in[I_CONVW] + (size_t)l * 3 * XBCW + c0; const float* cbp = a.in[I_CONVB] + (size_t)l * XBCW + c0;
            float w0[8], w1[8], w2[8], bs[8];
#pragma unroll
            for (int e = 0; e < 8; ++e) { w0[e] = cw[e]; w1[e] = cw[XBCW + e]; w2[e] = cw[2 * XBCW + e]; bs[e] = cbp[e]; }
            const bf16_t* base = P + (size_t)t0 * PW + PC_XBC + c0; bf16_t* ob = XB + (size_t)t0 * XBCW + c0;
            const u32x4 zz = zero4();
            const bool tail_ok = pos0 + 32 < L;
            u32x4 R[10], N[8];
            R[0] = pos0 > 0 ? *(const u32x4*)(base - PW) : zz; R[1] = *(const u32x4*)base;
#pragma unroll
            for (int j = 0; j < 8; ++j) R[2 + j] = *(const u32x4*)(base + (size_t)(1 + j) * PW);
            for (int blk = 0; blk < 4; ++blk) {
                const int i0 = blk * 8;
                if (blk < 3) {
#pragma unroll
                    for (int j = 0; j < 8; ++j) { const int idx = i0 + 9 + j; N[j] = (idx < 32 || tail_ok) ? *(const u32x4*)(base + (size_t)idx * PW) : zz; }
                }
#pragma unroll
                for (int j = 0; j < 8; ++j) {
                    float xa[8], xb[8], xc[8], o[8]; unpack8(R[j], xa); unpack8(R[j + 1], xb); unpack8(R[j + 2], xc);
#pragma unroll
                    for (int e = 0; e < 8; ++e) o[e] = siluf_(bs[e] + w0[e] * xa[e] + w1[e] * xb[e] + w2[e] * xc[e]);
                    *(u32x4*)(ob + (size_t)(i0 + j) * XBCW) = pack8(o);
                }
                R[0] = R[8]; R[1] = R[9];
#pragma unroll
                for (int j = 0; j < 8; ++j) R[2 + j] = N[j];
            }
            continue;
        }
        const int id3 = id2 - NRUN * 6, run = id3 / 3, sub = id3 % 3, t0 = run * 32;
        const bool lat = t0 >= NCTX; const int tt0 = lat ? t0 - NCTX : t0; const int sb = lat ? tt0 >> 12 : tt0 >> 8, pos0 = lat ? tt0 & 4095 : tt0 & 255;
        const int li = lane & 15, d0 = li * 8; const int hq = sub * 4 + (lane >> 4);
        const bool isq = sub < 2, isv = !isq && lane >= 32; const int kvh = (lane >> 4) & 1;
        const int scol = isq ? PC_Q + hq * 128 + d0 : (isv ? PC_V : PC_K) + kvh * 128 + d0;
        float nwv[8];
        { const float* nw = a.in[isq ? I_QN : I_KN] + l * 128 + d0;
#pragma unroll
          for (int e = 0; e < 8; ++e) nwv[e] = nw[e]; }
        const bool first = (li & 7) < 4; const int fi = ((li & 3) * 8);
        const bf16_t* src0 = P + (size_t)t0 * PW + scol;
        for (int blk = 0; blk < 4; ++blk) {
        u32x4 RR[8];
#pragma unroll
        for (int j = 0; j < 8; ++j) RR[j] = *(const u32x4*)(src0 + (size_t)(blk * 8 + j) * PW);
#pragma unroll
        for (int j = 0; j < 8; ++j) {
            const int i = blk * 8 + j; const u32x4 cur = RR[j];
            const int t = t0 + i, pos = pos0 + i;
            float xv[8]; unpack8(cur, xv);
            float ss = 0.f;
#pragma unroll
            for (int e = 0; e < 8; ++e) ss += xv[e] * xv[e];
            ss += __shfl_xor(ss, 1); ss += __shfl_xor(ss, 2); ss += __shfl_xor(ss, 4); ss += __shfl_xor(ss, 8);
            const float rstd = rsqrtf(ss * (1.f / 128.f) + EPS);
            float y[8];
#pragma unroll
            for (int e = 0; e < 8; ++e) y[e] = isv ? xv[e] : xv[e] * rstd * nwv[e];
            const int pr = pos >> 6, pc = pos & 63; const int pp = (li >> 3) ? pc : pr;
            const f32x4 cs0 = *(const f32x4*)(rt + pp * 32 + fi), cs1 = *(const f32x4*)(rt + pp * 32 + fi + 4), sn0 = *(const f32x4*)(rt + 2048 + pp * 32 + fi), sn1 = *(const f32x4*)(rt + 2048 + pp * 32 + fi + 4);
            const float csv[8] = {cs0.x, cs0.y, cs0.z, cs0.w, cs1.x, cs1.y, cs1.z, cs1.w}, snv[8] = {sn0.x, sn0.y, sn0.z, sn0.w, sn1.x, sn1.y, sn1.z, sn1.w};
            float o[8];
#pragma unroll
            for (int e = 0; e < 8; ++e) { const float xp = __shfl_xor(y[e], 4); const float r = y[e] * csv[e] + (first ? -xp : xp) * snv[e]; o[e] = (lat && !isv) ? r : y[e]; }
            const u32x4 w = pack8(o);
            if (isq) { *(u32x4*)(Q + (size_t)t * DM + hq * 128 + d0) = w; }
            else {
                const size_t krow = lat ? (size_t)(NCTX + sb * LKV + PAST + pos) : (size_t)t;
                *(u32x4*)((isv ? VB : KB) + krow * 256 + kvh * 128 + d0) = w;
                if (!lat) { float* dst = a.out + (isv ? O_CV : O_CK) + (((size_t)sb * DEPTH + l) * 256 + pos) * 256 + kvh * 128 + d0;
                    *(f32x4*)dst = (f32x4){o[0], o[1], o[2], o[3]}; *(f32x4*)(dst + 4) = (f32x4){o[4], o[5], o[6], o[7]}; }
            }
        }
        }
    }
}

namespace sd {
constexpr int RS = 272, RSX = 160;
constexpr int L_C = 0, L_B = 128 * RS, L_X = 2 * 128 * RS, L_H0 = L_X + 128 * RSX, L_H1 = L_H0 + 64 * RS, L_CUM = L_H1 + 64 * RS, L_DT = L_CUM + 512, L_WG = L_DT + 512, L_Y = L_WG + 512, RSY = 144, L_END = L_Y + 128 * RSY;
static_assert(L_END <= 144 * 1024 - 256, "ssd lds");
typedef short v4i16_t __attribute__((ext_vector_type(4)));
__device__ __forceinline__ f32x4 mfma16(bf16x8 a, bf16x8 b, f32x4 c) { return __builtin_amdgcn_mfma_f32_16x16x32_bf16(a, b, c, 0, 0, 0); }
__device__ __forceinline__ bf16x8 tr_frag(LAS unsigned char* p, int rs) {
    const v4i16_t lo = __builtin_amdgcn_ds_read_tr16_b64_v4i16((LAS v4i16_t*)p), hi = __builtin_amdgcn_ds_read_tr16_b64_v4i16((LAS v4i16_t*)(p + 4 * rs));
    return (bf16x8){lo[0], lo[1], lo[2], lo[3], hi[0], hi[1], hi[2], hi[3]};
}
__device__ __forceinline__ void ssd_item(const Ctx& c, int l, int item) {
    CArgs& a = *c.a; LAS unsigned char* lds = c.lds;
    const int tid = c.tid, lane = c.lane, w = c.wid, fr = lane & 15, fq = lane >> 4, tq = (lane & 15) >> 2, tp = lane & 3;
    int sb, dir, h, row_base, nc; bool lat;
    if (item < 128) { lat = true; sb = item >> 6; dir = (item >> 5) & 1; h = item & 31; row_base = NCTX + sb * 4096; nc = 32; }
    else { const int it = item - 128; lat = false; sb = it >> 6; dir = (it >> 5) & 1; h = it & 31; row_base = sb * 256; nc = 2; }
    const int g = h >> 3, dcol = dir * 32 + h; const float dskv = a.in[I_DSKIP][l * 32 + h];
    const bf16_t* XB = (const bf16_t*)(a.ws + WS_XBC); bf16_t* Y = (bf16_t*)(a.ws + (dir ? WS_YB : WS_YF));
    const float* dv = (const float*)(a.ws + WS_DTV); const float* cm = (const float*)(a.ws + WS_CUM);
    f32x4 hacc[4];
    if (lat) { const float* st = a.in[I_ST] + ((((size_t)sb * DEPTH + l) * 2 + dir) * 32 + h) * 8192;
#pragma unroll
        for (int pt = 0; pt < 4; ++pt)
#pragma unroll
            for (int j = 0; j < 4; ++j) hacc[pt][j] = st[(16 * pt + 4 * fq + j) * 128 + 16 * w + fr]; }
    else {
#pragma unroll
        for (int pt = 0; pt < 4; ++pt) hacc[pt] = (f32x4){0.f, 0.f, 0.f, 0.f}; }
#pragma unroll
    for (int pt = 0; pt < 4; ++pt)
#pragma unroll
        for (int j = 0; j < 4; ++j) *(LAS bf16_t*)(lds + L_H0 + (16 * pt + 4 * fq + j) * RS + (16 * w + fr) * 2) = (bf16_t)(cvtpk(hacc[pt][j], 0.f) & 0xffffu);
    LAS float* cumS = (LAS float*)(lds + L_CUM); LAS float* dtS = (LAS float*)(lds + L_DT); LAS float* wgS = (LAS float*)(lds + L_WG);
    const int ll = tid & 127;
    u32x4 pcv[4], pbv[4], pxv[2]; float pcmr, pdvr, pclast;
#define SSD_LOAD(cs_) do { const int ch_ = dir ? nc - 1 - (cs_) : (cs_); const int r0_ = row_base + ch_ * 128; \
        pclast = cm[(size_t)(r0_ + (dir ? 0 : 127)) * 64 + dcol]; \
        { const int row_ = r0_ + (dir ? 127 - ll : ll); pcmr = cm[(size_t)row_ * 64 + dcol]; pdvr = dv[(size_t)row_ * 64 + dcol]; } \
        _Pragma("unroll") for (int i = 0; i < 4; ++i) { const int q_ = tid + 512 * i, l_ = q_ >> 4, cx = q_ & 15; const bf16_t* xr_ = XB + (size_t)(r0_ + (dir ? 127 - l_ : l_)) * XBCW; \
            pcv[i] = *(const u32x4*)(xr_ + 2560 + g * 128 + cx * 8); pbv[i] = *(const u32x4*)(xr_ + 2048 + g * 128 + cx * 8); } \
        _Pragma("unroll") for (int i = 0; i < 2; ++i) { const int q_ = tid + 512 * i, l_ = q_ >> 3, cx = q_ & 7; const bf16_t* xr_ = XB + (size_t)(r0_ + (dir ? 127 - l_ : l_)) * XBCW; \
            pxv[i] = *(const u32x4*)(xr_ + h * 64 + cx * 8); } } while (0)
    SSD_LOAD(0);
    const int xoff = L_X + (8 * fq + tq) * RSX + 8 * tp, boff = L_B + (8 * fq + tq) * RS + (16 * w) * 2 + 8 * tp;
    for (int cs = 0; cs < nc; ++cs) {
        const int ch = dir ? nc - 1 - cs : cs; const int r0 = row_base + ch * 128;
        const int hcur = (cs & 1) ? L_H1 : L_H0, hnxt = (cs & 1) ? L_H0 : L_H1;
        const float cum_last = pclast;
        if (tid < 128) { cumS[ll] = pcmr; dtS[ll] = pdvr; wgS[ll] = __expf(cum_last - pcmr) * pdvr; }
#pragma unroll
        for (int i = 0; i < 4; ++i) { const int q_ = tid + 512 * i, l_ = q_ >> 4, cx = q_ & 15; *(LAS u32x4*)(lds + L_C + l_ * RS + cx * 16) = pcv[i]; *(LAS u32x4*)(lds + L_B + l_ * RS + cx * 16) = pbv[i]; }
#pragma unroll
        for (int i = 0; i < 2; ++i) { const int q_ = tid + 512 * i, l_ = q_ >> 3, cx = q_ & 7; *(LAS u32x4*)(lds + L_X + l_ * RSX + cx * 16) = pxv[i]; }
        if (cs + 1 < nc) SSD_LOAD(cs + 1);
        asm volatile("s_waitcnt lgkmcnt(0)" ::: "memory"); __builtin_amdgcn_s_barrier(); asm volatile("" ::: "memory");
        bf16x8 cfr[4];
#pragma unroll
        for (int ks = 0; ks < 4; ++ks) cfr[ks] = *(const LAS bf16x8*)(lds + L_C + (16 * w + fr) * RS + ks * 64 + fq * 16);
        float cl[4];
#pragma unroll
        for (int j = 0; j < 4; ++j) cl[j] = cumS[16 * w + 4 * fq + j];
        for (int ct = 0; ct <= w; ct += 2) {
            f32x4 cb0 = (f32x4){0.f, 0.f, 0.f, 0.f}, cb1 = (f32x4){0.f, 0.f, 0.f, 0.f};
#pragma unroll
            for (int ks = 0; ks < 4; ++ks) { cb0 = mfma16(cfr[ks], *(const LAS bf16x8*)(lds + L_B + (16 * ct + fr) * RS + ks * 64 + fq * 16), cb0);
                                             cb1 = mfma16(cfr[ks], *(const LAS bf16x8*)(lds + L_B + (16 * ct + 16 + fr) * RS + ks * 64 + fq * 16), cb1); }
            const int s0 = 16 * ct + fr, s1 = s0 + 16; const float csv0 = cumS[s0], dts0 = dtS[s0], csv1 = cumS[s1], dts1 = dtS[s1];
#pragma unroll
            for (int j = 0; j < 4; ++j) { const int lrow = 16 * w + 4 * fq + j;
                const float wv0 = (s0 <= lrow) ? cb0[j] * __expf(cl[j] - csv0) * dts0 : 0.f, wv1 = (s1 <= lrow) ? cb1[j] * __expf(cl[j] - csv1) * dts1 : 0.f;
                *(LAS bf16_t*)(lds + L_C + lrow * RS + s0 * 2) = (bf16_t)(cvtpk(wv0, 0.f) & 0xffffu); *(LAS bf16_t*)(lds + L_C + lrow * RS + s1 * 2) = (bf16_t)(cvtpk(wv1, 0.f) & 0xffffu); }
        }
        bf16x8 btf[4];
#pragma unroll
        for (int ks = 0; ks < 4; ++ks) {
            const bf16x8 raw = tr_frag(lds + boff + ks * 32 * RS, RS);
            const f32x4 w0 = *(const LAS f32x4*)(wgS + ks * 32 + 8 * fq), w1 = *(const LAS f32x4*)(wgS + ks * 32 + 8 * fq + 4);
            u32x4 rw = __builtin_bit_cast(u32x4, raw);
            u32x4 o; o.x = cvtpk(bflo(rw.x) * w0.x, bfhi(rw.x) * w0.y); o.y = cvtpk(bflo(rw.y) * w0.z, bfhi(rw.y) * w0.w); o.z = cvtpk(bflo(rw.z) * w1.x, bfhi(rw.z) * w1.y); o.w = cvtpk(bflo(rw.w) * w1.z, bfhi(rw.w) * w1.w);
            btf[ks] = __builtin_bit_cast(bf16x8, o);
        }
        const float ed = __expf(cum_last);
        const int ksmax = (16 * w + 15) >> 5;
        float el[4];
#pragma unroll
        for (int j = 0; j < 4; ++j) el[j] = __expf(cl[j]);
#pragma unroll
        for (int pt = 0; pt < 4; ++pt) {
            bf16x8 xf[4];
#pragma unroll
            for (int ks = 0; ks < 4; ++ks) xf[ks] = tr_frag(lds + xoff + ks * 32 * RSX + pt * 32, RSX);
            f32x4 yo = (f32x4){0.f, 0.f, 0.f, 0.f}, yd = (f32x4){0.f, 0.f, 0.f, 0.f};
#pragma unroll
            for (int ks = 0; ks < 4; ++ks) yo = mfma16(cfr[ks], *(const LAS bf16x8*)(lds + hcur + (16 * pt + fr) * RS + ks * 64 + fq * 16), yo);
#pragma unroll
            for (int ks = 0; ks < 4; ++ks) if (ks <= ksmax) yd = mfma16(*(const LAS bf16x8*)(lds + L_C + (16 * w + fr) * RS + ks * 64 + fq * 16), xf[ks], yd);
            hacc[pt] = hacc[pt] * ed;
#pragma unroll
            for (int ks = 0; ks < 4; ++ks) hacc[pt] = mfma16(xf[ks], btf[ks], hacc[pt]);
#pragma unroll
            for (int j = 0; j < 4; ++j) { const int lr = 16 * w + 4 * fq + j;
                *(LAS bf16_t*)(lds + L_Y + lr * RSY + (16 * pt + fr) * 2) = (bf16_t)(cvtpk(yd[j] + el[j] * yo[j], 0.f) & 0xffffu); }
#pragma unroll
            for (int j = 0; j < 4; ++j) *(LAS bf16_t*)(lds + hnxt + (16 * pt + 4 * fq + j) * RS + (16 * w + fr) * 2) = (bf16_t)(cvtpk(hacc[pt][j], 0.f) & 0xffffu);
        }
#pragma unroll
        for (int i = 0; i < 2; ++i) { const int lr = 16 * w + 8 * i + (lane >> 3), cx = lane & 7; const int row = r0 + (dir ? 127 - lr : lr);
            u32x4 yv = *(const LAS u32x4*)(lds + L_Y + lr * RSY + cx * 16);
            if (dir == 0) { float yf[8], xf2[8]; unpack8(yv, yf); unpack8(*(const LAS u32x4*)(lds + L_X + lr * RSX + cx * 16), xf2);
#pragma unroll
                for (int e2 = 0; e2 < 8; ++e2) yf[e2] += dskv * xf2[e2];
                yv = pack8(yf); }
            *(u32x4*)(Y + (size_t)row * DIN + h * 64 + cx * 8) = yv; }
        asm volatile("s_waitcnt lgkmcnt(0)" ::: "memory"); __builtin_amdgcn_s_barrier(); asm volatile("" ::: "memory");
    }
#undef SSD_LOAD
    if (!lat) { float* st = a.out + O_ST + ((((size_t)sb * DEPTH + l) * 2 + dir) * 32 + h) * 8192;
#pragma unroll
        for (int pt = 0; pt < 4; ++pt)
#pragma unroll
            for (int j = 0; j < 4; ++j) st[(16 * pt + 4 * fq + j) * 128 + 16 * w + fr] = hacc[pt][j]; }
}
}

__device__ __forceinline__ void mixer_phase(const Ctx& c, int l, int r) {
    CArgs& a = *c.a; unsigned* ctr = (unsigned*)(a.ws + WS_CTL) + 64 * l + 16 * r;
    LAS int* slot = (LAS int*)(c.lds + LDS_BYTES - 64);
    const bf16_t* Q = (const bf16_t*)(a.ws + WS_Q); const bf16_t* KB = (const bf16_t*)(a.ws + WS_K); const bf16_t* VB = (const bf16_t*)(a.ws + WS_V); bf16_t* AO = (bf16_t*)(a.ws + WS_AO);
    constexpr int N_SL = 128, N_AL = 256, N_SC = 1024, N_AC = 128, N_ALL = N_SL + N_AL + N_SC + N_AC;
    for (;;) {
        __syncthreads();
        if (c.tid == 0) *slot = (int)atomicAdd(ctr, 1u);
        __syncthreads();
        const int it = __builtin_amdgcn_readfirstlane(*slot);
        if (it >= N_ALL) break;
        const bool is_ssd = it < N_SL || (it >= N_SL + N_AL && it < N_SL + N_AL + N_SC);
        Ctx c2 = c; { const int t_ = fresh_tid(c.wid); c2.tid = t_; c2.lane = t_ & 63; }
        if (is_ssd) { sd::ssd_item(c2, l, it < N_SL ? it : it - N_AL); }
        else {
            size_t qrow, krow; int hq, seq;
            if (it < N_SL + N_AL) { const int u = it - N_SL, b = u >> 7, rem = u & 127, kvh = rem >> 6, r2 = rem & 63, qb = r2 >> 2; hq = kvh * 4 + (r2 & 3);
                qrow = (size_t)NCTX + b * 4096 + qb * 256; krow = (size_t)NCTX + b * LKV; seq = LKV; }
            else { const int u = it - N_SL - N_AL - N_SC, b = u >> 3; hq = u & 7; qrow = (size_t)b * 256; krow = qrow; seq = 256; }
            const int kvh = hq >> 2;
            at::attn_body(Q + qrow * DM + hq * 128, KB + krow * 256 + kvh * 128, VB + krow * 256 + kvh * 128, AO + qrow * DM + hq * 128, seq, c.ldsg, c2.tid);
        }
    }
}

__device__ __forceinline__ void ssd_gate_phase(const Ctx& c, int l) {
    CArgs& a = *c.a; bf16_t* YF = (bf16_t*)(a.ws + WS_YF); const bf16_t* YB = (const bf16_t*)(a.ws + WS_YB); const bf16_t* XB = (const bf16_t*)(a.ws + WS_XBC); const bf16_t* P = (const bf16_t*)(a.ws + WS_P);
    const float* nw = a.in[I_SSDN] + (size_t)l * DIN;
    for (int t = c.gw; t < T; t += c.ngw) {
        float y[4][8]; float ss = 0.f;
#pragma unroll
        for (int j = 0; j < 4; ++j) { const int col = j * 512 + c.lane * 8;
            float f[8], b[8], z[8];
            unpack8(*(const u32x4*)(YF + (size_t)t * DIN + col), f); unpack8(*(const u32x4*)(YB + (size_t)t * DIN + col), b);
            unpack8(*(const u32x4*)(P + (size_t)t * PW + PC_Z + col), z);
#pragma unroll
            for (int e = 0; e < 8; ++e) { const float v = (f[e] + b[e]) * siluf_(z[e]); y[j][e] = v; ss += v * v; } }
        const float rstd = rsqrtf(wave_sum(ss) * (1.f / DIN) + EPS);
#pragma unroll
        for (int j = 0; j < 4; ++j) { const int col = j * 512 + c.lane * 8; const f32x4 w0 = *(const f32x4*)(nw + col), w1 = *(const f32x4*)(nw + col + 4);
            float o[8] = {y[j][0] * rstd * w0.x, y[j][1] * rstd * w0.y, y[j][2] * rstd * w0.z, y[j][3] * rstd * w0.w, y[j][4] * rstd * w1.x, y[j][5] * rstd * w1.y, y[j][6] * rstd * w1.z, y[j][7] * rstd * w1.w};
            *(u32x4*)(YF + (size_t)t * DIN + col) = pack8(o); }
    }
}

__device__ __forceinline__ void ffn_act_phase(const Ctx& c, int l) {
    CArgs& a = *c.a; const bf16_t* U = (const bf16_t*)(a.ws + WS_P); bf16_t* ACT = (bf16_t*)(a.ws + WS_XBC);
    const float* fw = a.in[I_FCW] + (size_t)l * 3 * UPW; const float* fb = a.in[I_FCB] + (size_t)l * UPW;
    constexpr int NRUN = T / 32;
    for (int id = c.gw; id < NRUN * 6; id += c.ngw) {
        const int run = id / 6, wt = id % 6, t0 = run * 32; const int ci = wt * 64 + c.lane; if (ci >= DFF / 8) continue; const int c0 = ci * 8;
        const bool lat = t0 >= NCTX; const int tt = lat ? t0 - NCTX : t0; const int pos0 = lat ? tt & 4095 : tt & 255, L = lat ? 4096 : 256;
        float wv0[8], wv1[8], wv2[8], wg0[8], wg1[8], wg2[8], bv[8], bg[8];
#pragma unroll
        for (int e = 0; e < 8; ++e) { wv0[e] = fw[c0 + e]; wv1[e] = fw[UPW + c0 + e]; wv2[e] = fw[2 * UPW + c0 + e]; wg0[e] = fw[DFF + c0 + e]; wg1[e] = fw[UPW + DFF + c0 + e]; wg2[e] = fw[2 * UPW + DFF + c0 + e];
            bv[e] = fb[c0 + e]; bg[e] = fb[DFF + c0 + e]; }
        const bf16_t* base = U + (size_t)t0 * UPW + c0; bf16_t* ob = ACT + (size_t)t0 * DFF + c0;
        const u32x4 zz = zero4();
        const bool tail_ok = pos0 + 32 < L;
        u32x4 V[10], G[10], NV[8], NG[8];
        V[0] = zz; G[0] = zz; if (pos0 > 0) { V[0] = *(const u32x4*)(base - UPW); G[0] = *(const u32x4*)(base - UPW + DFF); }
        V[1] = *(const u32x4*)base; G[1] = *(const u32x4*)(base + DFF);
#pragma unroll
        for (int j = 0; j < 8; ++j) { V[2 + j] = *(const u32x4*)(base + (size_t)(1 + j) * UPW); G[2 + j] = *(const u32x4*)(base + (size_t)(1 + j) * UPW + DFF); }
        for (int blk = 0; blk < 4; ++blk) {
            const int i0 = blk * 8;
            if (blk < 3) {
#pragma unroll
                for (int j = 0; j < 8; ++j) { const int idx = i0 + 9 + j;
                    if (idx < 32 || tail_ok) { NV[j] = *(const u32x4*)(base + (size_t)idx * UPW); NG[j] = *(const u32x4*)(base + (size_t)idx * UPW + DFF); } else { NV[j] = zz; NG[j] = zz; } }
            }
#pragma unroll
            for (int j = 0; j < 8; ++j) {
                float xa[8], xb[8], xc[8], ya[8], yb[8], yc[8], o[8];
                unpack8(V[j], xa); unpack8(V[j + 1], xb); unpack8(V[j + 2], xc); unpack8(G[j], ya); unpack8(G[j + 1], yb); unpack8(G[j + 2], yc);
#pragma unroll
                for (int e = 0; e < 8; ++e) { const float uv = bv[e] + wv0[e] * xa[e] + wv1[e] * xb[e] + wv2[e] * xc[e]; const float ug = bg[e] + wg0[e] * ya[e] + wg1[e] * yb[e] + wg2[e] * yc[e]; o[e] = siluf_(ug) * uv; }
                *(u32x4*)(ob + (size_t)(i0 + j) * DFF) = pack8(o);
            }
            V[0] = V[8]; V[1] = V[9]; G[0] = G[8]; G[1] = G[9];
#pragma unroll
            for (int j = 0; j < 8; ++j) { V[2 + j] = NV[j]; G[2 + j] = NG[j]; }
        }
    }
}

namespace pg8 {
using gm::BM; using gm::BK; using gm::HALF; using gm::HTB; using gm::NXCD; using gm::WGM; using gm::lds_byte; using gm::stage_rc;
#define PG8_LAS LAS
__host__ __device__ __forceinline__ int perm32(int rho) { const int n = rho >> 4, i = rho & 15; return 8 * (i >> 2) + 4 * n + (i & 3); }
struct Unit { int pm, pn; };
struct Gemm { const bf16_t* A; const bf16_t* Bt; int M, N, K; };

struct StaticOrder {
    int nM, nN, nwg, G, c;
    __host__ __device__ void init(int M, int N, int G_, int c_, int bm = BM) { nM = M / bm; nN = N / BM; nwg = nM * nN; G = G_; c = c_; }
    __host__ __device__ bool next(int i, Unit& u) const {
        const long L = (long)i * G + c; if (L >= nwg) return false;
        int wgid = (int)L; { const int q = nwg / NXCD, r = nwg % NXCD, xcd = wgid % NXCD, off = wgid / NXCD; wgid = (xcd < r ? xcd * (q + 1) : r * (q + 1) + (xcd - r) * q) + off; }
        const int nig = WGM * nN, gid = wgid / nig, fm = gid * WGM, gsz = (nM - fm) < WGM ? (nM - fm) : WGM;
        u.pm = fm + ((wgid % nig) % gsz); u.pn = (wgid % nig) / gsz; return true;
    }
    __device__ __forceinline__ void a_ready(const Unit&) const {}
    __device__ __forceinline__ void done(const Unit&) const {}
};
template <class Epi, class Sched, bool ALIGN_EPI = false, bool SP2 = false, int MT = 4>
__device__ __forceinline__ void gemm_phase(PG8_LAS unsigned char* lds, const int tid, const Gemm g, const Sched& S, const Epi& E) {
    const int wid = __builtin_amdgcn_readfirstlane(tid >> 6), lane = tid & 63, wr = wid >> 2, wc = wid & 3, fr = lane & 15, fq = lane >> 4;
    const int K = g.K, nt = K / BK;
    unsigned voffA[2], voffB[2];
#pragma unroll
    for (int i = 0; i < 2; ++i) { int R, C; stage_rc(tid * 16 + i * 8192, R, C); const int Rb = Epi::PERM ? ((R & ~31) + perm32(R & 31)) : R;
        voffA[i] = (unsigned)(R * K + C) * 2u; voffB[i] = (unsigned)(Rb * K + C) * 2u; }
    const size_t kstep = (size_t)(BK * 2);
    const size_t hstepA = (size_t)(MT * 32) * K * 2, hstepB = (size_t)HALF * K * 2;
    const size_t tstepA = 2 * hstepA, tstepB = 2 * hstepB;
    const unsigned ldsw = (unsigned)wid * 1024u;
    const int aoff = lds_byte(wr * (MT * 16) + fr, fq * 8), boff = lds_byte(wc * 32 + fr, fq * 8);
#define PG8_SA(b, h) (((b) * 2 + (h)) * HTB)
#define PG8_SB(b, h) ((4 + (b) * 2 + (h)) * HTB)
#define PG8_STAGE(bufoff, gbase, voff) do { _Pragma("unroll") for (int _i = 0; _i < 2; ++_i) \
        __builtin_amdgcn_global_load_lds((const unsigned*)((const char*)(gbase) + (voff)[_i]), (PG8_LAS unsigned*)(lds + (bufoff) + ldsw + _i * 8192), 16, 0, 0); } while (0)
#define PG8_LDA(dst, b, h) do { _Pragma("unroll") for (int m = 0; m < MT; ++m) _Pragma("unroll") for (int k = 0; k < 2; ++k) dst[m][k] = *(const PG8_LAS bf16x8*)(lds + PG8_SA(b, h) + aoff + m * 2048 + k * 1024); } while (0)
#define PG8_LDB(dst, b, h) do { _Pragma("unroll") for (int n = 0; n < 2; ++n) _Pragma("unroll") for (int k = 0; k < 2; ++k) dst[n][k] = *(const PG8_LAS bf16x8*)(lds + PG8_SB(b, h) + boff + n * 2048 + k * 1024); } while (0)
#define PG8_MMA(ai, bj, At, Bt) do { __builtin_amdgcn_s_setprio(1); _Pragma("unroll") for (int m = 0; m < MT; ++m) _Pragma("unroll") for (int n = 0; n < 2; ++n) _Pragma("unroll") for (int k = 0; k < 2; ++k) \
        acc[ai][bj][m][n] = __builtin_amdgcn_mfma_f32_16x16x32_bf16(Bt[n][k], At[m][k], acc[ai][bj][m][n], 0, 0, 0); __builtin_amdgcn_s_setprio(0); } while (0)
#define PG8_WAIT_V(n) asm volatile("s_waitcnt vmcnt(" #n ")" ::: "memory")
#define PG8_WAIT_L(n) asm volatile("s_waitcnt lgkmcnt(" #n ")" ::: "memory")
#define PG8_BAR __builtin_amdgcn_s_barrier()
#define PG8_SCHED __builtin_amdgcn_sched_barrier(0)
    Unit cur, nxt; int ui = 0;
    if (!S.next(0, cur)) return;
    f32x4 acc[2][2][4][2];
#pragma unroll
    for (int a = 0; a < 2; ++a)
#pragma unroll
        for (int b = 0; b < 2; ++b)
#pragma unroll
            for (int m = 0; m < 4; ++m)
#pragma unroll
                for (int n = 0; n < 2; ++n) acc[a][b][m][n] = (f32x4){0.f, 0.f, 0.f, 0.f};
    bf16x8 At[4][2], B0[2][2], B1[2][2];
    const char* cA = (const char*)g.A + (size_t)cur.pm * tstepA; const char* cB = (const char*)g.Bt + (size_t)cur.pn * tstepB;
    S.a_ready(cur);
    if constexpr (SP2) {
        PG8_STAGE(PG8_SB(0, 0), cB, voffB); PG8_STAGE(PG8_SB(0, 1), cB + hstepB, voffB); PG8_STAGE(PG8_SA(0, 0), cA, voffA); PG8_STAGE(PG8_SA(0, 1), cA + hstepA, voffA);
        if (wr == 1) PG8_BAR;
        PG8_WAIT_V(2); PG8_BAR;
        PG8_STAGE(PG8_SB(1, 0), cB + kstep, voffB); PG8_STAGE(PG8_SA(1, 0), cA + kstep, voffA); PG8_STAGE(PG8_SB(1, 1), cB + hstepB + kstep, voffB);
        PG8_WAIT_V(6); PG8_BAR;
    } else {
        PG8_STAGE(PG8_SB(0, 0), cB, voffB); PG8_STAGE(PG8_SA(0, 0), cA, voffA); PG8_STAGE(PG8_SB(0, 1), cB + hstepB, voffB); PG8_STAGE(PG8_SA(0, 1), cA + hstepA, voffA);
        if (wr == 1) PG8_BAR;
        PG8_WAIT_V(4); PG8_BAR;
        PG8_STAGE(PG8_SB(1, 0), cB + kstep, voffB); PG8_STAGE(PG8_SA(1, 0), cA + kstep, voffA); PG8_STAGE(PG8_SB(1, 1), cB + hstepB + kstep, voffB);
        PG8_WAIT_V(6); PG8_BAR;
    }
    for (;;) {
        const bool has_next = S.next(ui + 1, nxt);
        const char* nA = has_next ? (const char*)g.A + (size_t)nxt.pm * tstepA : cA; const char* nB = has_next ? (const char*)g.Bt + (size_t)nxt.pn * tstepB : cB;
        for (int t = 0; t < nt; t += 2) {
            const bool last = (t == nt - 2);
            const char* a1 = cA + (size_t)(t + 1) * kstep;
            const char* a2 = last ? nA : cA + (size_t)(t + 2) * kstep; const char* b2 = last ? nB : cB + (size_t)(t + 2) * kstep;
            const char* a3 = a2 + kstep; const char* b3 = b2 + kstep;
            if (last && has_next) S.a_ready(nxt);
            if constexpr (SP2) {
            PG8_LDB(B0, 0, 0); PG8_LDB(B1, 0, 1); PG8_SCHED; PG8_LDA(At, 0, 0); PG8_STAGE(PG8_SA(1, 1), a1 + hstepA, voffA);
            PG8_WAIT_V(8); PG8_WAIT_L(0); PG8_BAR; PG8_MMA(0, 0, At, B0); PG8_MMA(0, 1, At, B1); PG8_BAR; PG8_SCHED;
            PG8_LDA(At, 0, 1); PG8_STAGE(PG8_SB(0, 0), b2, voffB); PG8_STAGE(PG8_SB(0, 1), b2 + hstepB, voffB); PG8_STAGE(PG8_SA(0, 0), a2, voffA);
            PG8_WAIT_V(8); PG8_WAIT_L(0); PG8_BAR; PG8_MMA(1, 0, At, B0); PG8_MMA(1, 1, At, B1); PG8_BAR; PG8_SCHED;
            PG8_LDB(B0, 1, 0); PG8_LDB(B1, 1, 1); PG8_SCHED; PG8_LDA(At, 1, 0); PG8_STAGE(PG8_SA(0, 1), a2 + hstepA, voffA);
            PG8_WAIT_V(8); PG8_WAIT_L(0); PG8_BAR; PG8_MMA(0, 0, At, B0); PG8_MMA(0, 1, At, B1); PG8_BAR; PG8_SCHED;
            PG8_LDA(At, 1, 1); PG8_STAGE(PG8_SB(1, 0), b3, voffB); PG8_STAGE(PG8_SB(1, 1), b3 + hstepB, voffB); PG8_STAGE(PG8_SA(1, 0), a3, voffA);
            PG8_WAIT_V(8); PG8_WAIT_L(0); PG8_BAR; PG8_MMA(1, 0, At, B0); PG8_MMA(1, 1, At, B1); PG8_BAR; PG8_SCHED;
            } else {
            PG8_LDB(B0, 0, 0); PG8_SCHED; PG8_LDA(At, 0, 0); PG8_STAGE(PG8_SA(1, 1), a1 + hstepA, voffA);
            PG8_WAIT_L(8); PG8_BAR; PG8_WAIT_L(0); PG8_MMA(0, 0, At, B0); PG8_BAR; PG8_SCHED;
            PG8_LDB(B1, 0, 1); PG8_STAGE(PG8_SB(0, 0), b2, voffB);
            PG8_BAR; PG8_WAIT_L(0); PG8_MMA(0, 1, At, B1); PG8_BAR;
            PG8_LDA(At, 0, 1); PG8_STAGE(PG8_SA(0, 0), a2, voffA);
            PG8_BAR; PG8_WAIT_L(0); PG8_MMA(1, 0, At, B0); PG8_BAR; PG8_SCHED;
            PG8_STAGE(PG8_SB(0, 1), b2 + hstepB, voffB);
            PG8_WAIT_V(6); PG8_BAR; PG8_MMA(1, 1, At, B1); PG8_BAR;
            PG8_LDB(B0, 1, 0); PG8_SCHED; PG8_LDA(At, 1, 0); PG8_STAGE(PG8_SA(0, 1), a2 + hstepA, voffA);
            PG8_WAIT_L(8); PG8_BAR; PG8_WAIT_L(0); PG8_MMA(0, 0, At, B0); PG8_BAR; PG8_SCHED;
            PG8_LDB(B1, 1, 1); PG8_STAGE(PG8_SB(1, 0), b3, voffB);
            PG8_BAR; PG8_WAIT_L(0); PG8_MMA(0, 1, At, B1); PG8_BAR;
            PG8_LDA(At, 1, 1); PG8_STAGE(PG8_SA(1, 0), a3, voffA);
            PG8_BAR; PG8_WAIT_L(0); PG8_MMA(1, 0, At, B0); PG8_BAR; PG8_SCHED;
            PG8_STAGE(PG8_SB(1, 1), b3 + hstepB, voffB);
            PG8_WAIT_V(6); PG8_BAR; PG8_MMA(1, 1, At, B1); PG8_BAR;
            }
        }
        if constexpr (ALIGN_EPI) { if (wr == 0) PG8_BAR; }
        if constexpr (!Epi::AFTER_DRAIN) { E(acc, cur, wr, wc, fr, fq); S.done(cur); }
        if (!has_next) break;
#pragma unroll
        for (int a = 0; a < 2; ++a)
#pragma unroll
            for (int b = 0; b < 2; ++b)
#pragma unroll
                for (int m = 0; m < 4; ++m)
#pragma unroll
                    for (int n = 0; n < 2; ++n) acc[a][b][m][n] = (f32x4){0.f, 0.f, 0.f, 0.f};
        cur = nxt; cA = nA; cB = nB; ++ui;
        if constexpr (ALIGN_EPI) { if (wr == 1) PG8_BAR; }
    }
    PG8_WAIT_V(0);
    if constexpr (!ALIGN_EPI) { if (wr == 0) PG8_BAR; }
    PG8_BAR;
    if constexpr (Epi::AFTER_DRAIN) { E.fused(acc, cur, wr, wc, fr, fq, lds, wid, lane); S.done(cur); }
#undef PG8_SA
#undef PG8_SB
#undef PG8_STAGE
#undef PG8_LDA
#undef PG8_LDB
#undef PG8_MMA
#undef PG8_WAIT_V
#undef PG8_WAIT_L
#undef PG8_BAR
#undef PG8_SCHED
}
}

struct EpiStoreBf16 {
    static constexpr bool PERM = true, AFTER_DRAIN = false;
    bf16_t* O; int ldc; float* DR; int dt_pn;
    __device__ __forceinline__ void operator()(const f32x4 (&acc)[2][2][4][2], const pg8::Unit& u, int wr, int wc, int fr, int fq) const {
        const int row0 = u.pm * 256 + wr * 64 + fr;
        if (u.pn != dt_pn) {
            const int col0 = u.pn * 256 + wc * 32 + 8 * fq;
#pragma unroll
            for (int ai = 0; ai < 2; ++ai)
#pragma unroll
                for (int m = 0; m < 4; ++m) { bf16_t* rowp = O + (size_t)(row0 + ai * 128 + m * 16) * ldc + col0;
#pragma unroll
                    for (int bj = 0; bj < 2; ++bj) { const f32x4 v0 = acc[ai][bj][m][0], v1 = acc[ai][bj][m][1];
                        u32x4 w; w.x = cvtpk(v0[0], v0[1]); w.y = cvtpk(v0[2], v0[3]); w.z = cvtpk(v1[0], v1[1]); w.w = cvtpk(v1[2], v1[3]);
                        *(u32x4*)(rowp + bj * 128) = w; } }
        } else if (wc < 2) {
#pragma unroll
            for (int ai = 0; ai < 2; ++ai)
#pragma unroll
                for (int m = 0; m < 4; ++m) { float* rp = DR + (size_t)(row0 + ai * 128 + m * 16) * 64 + wc * 32 + 8 * fq;
                    *(f32x4*)rp = acc[ai][0][m][0]; *(f32x4*)(rp + 4) = acc[ai][0][m][1]; }
        }
    }
};
template <bool SECOND, int MT> struct EpiGate {
    static constexpr bool PERM = true, AFTER_DRAIN = false;
    bf16_t* MG; const bf16_t* G;
    __device__ __forceinline__ void operator()(const f32x4 (&acc)[2][2][4][2], const pg8::Unit& u, int wr, int wc, int fr, int fq) const {
        const int row0 = u.pm * (64 * MT) + wr * (16 * MT) + fr, col0 = u.pn * 256 + wc * 32 + 8 * fq;
#pragma unroll
        for (int ai = 0; ai < 2; ++ai)
#pragma unroll
            for (int m = 0; m < MT; ++m) { const size_t row = (size_t)(row0 + ai * (32 * MT) + m * 16);
#pragma unroll
                for (int bj = 0; bj < 2; ++bj) { const int col = col0 + bj * 128;
                    float gv[8]; unpack8(*(const u32x4*)(G + row * PW + col), gv);
                    float t1[8] = {0.f, 0.f, 0.f, 0.f, 0.f, 0.f, 0.f, 0.f};
                    if (SECOND) unpack8(*(const u32x4*)(MG + row * DM + col), t1);
                    const f32x4 v0 = acc[ai][bj][m][0], v1 = acc[ai][bj][m][1];
                    float o[8];
#pragma unroll
                    for (int e = 0; e < 4; ++e) { o[e] = t1[e] + v0[e] * sigmoidf_(gv[e]); o[4 + e] = t1[4 + e] + v1[e] * sigmoidf_(gv[4 + e]); }
                    *(u32x4*)(MG + row * DM + col) = pack8(o); }
                asm volatile("" ::: "memory"); }
    }
};
template <int MT> struct EpiRes {
    static constexpr bool PERM = false, AFTER_DRAIN = false;
    float* X; const float* modl; bool fin;
    __device__ __forceinline__ void operator()(const f32x4 (&acc)[2][2][4][2], const pg8::Unit& u, int wr, int wc, int fr, int fq) const {
        const int row0 = u.pm * (64 * MT) + wr * (16 * MT) + fr, col0 = u.pn * 256 + wc * 32 + 4 * fq;
#pragma unroll
        for (int ai = 0; ai < 2; ++ai)
#pragma unroll
            for (int m = 0; m < MT; ++m) { const int row = row0 + ai * (32 * MT) + m * 16; float* xp = X + (size_t)row * DM + col0;
                const float* gp = modl + mod_idx(u.pm * (64 * MT) + wr * (16 * MT) + ai * (32 * MT) + m * 16) * 6144 + col0;
#pragma unroll
                for (int bj = 0; bj < 2; ++bj)
#pragma unroll
                    for (int n = 0; n < 2; ++n) { float* p = xp + bj * 128 + n * 16; const f32x4 gv = *(const f32x4*)(gp + bj * 128 + n * 16); if (fin) *(f32x4*)p = *(const f32x4*)p + gv * acc[ai][bj][m][n]; }
                asm volatile("" ::: "memory"); }
    }
};

__device__ __forceinline__ void g1_phase(const Ctx& c, int l) {
    CArgs& a = *c.a;
    pg8::Gemm g{(const bf16_t*)(a.ws + WS_H), (const bf16_t*)(a.ws + WS_W + (size_t)(l & 1) * WS_WSTRIDE) + W_IN, T, INWP, DM};
    pg8::StaticOrder S; S.init(T, INWP, (int)gridDim.x, (int)blockIdx.x);
    EpiStoreBf16 E{(bf16_t*)(a.ws + WS_P), PW, (float*)(a.ws + WS_DTR), INWP / 256 - 1};
    pg8::gemm_phase<EpiStoreBf16, pg8::StaticOrder, true, true>(c.lds, c.tid, g, S, E);
}
__device__ __forceinline__ void g2_phase(const Ctx& c, int l) {
    CArgs& a = *c.a; const bf16_t* W = (const bf16_t*)(a.ws + WS_W + (size_t)(l & 1) * WS_WSTRIDE); const bf16_t* P = (const bf16_t*)(a.ws + WS_P); bf16_t* MG = (bf16_t*)(a.ws + WS_H);
    if (blockIdx.x >= 192) {
        if (l + 1 < DEPTH) convert_weights(c, l + 1, (int)(blockIdx.x - 192) * 8 + c.wid, 64 * 8);
        return;
    }
    pg8::StaticOrder S; S.init(T, 1024, (int)gridDim.x, (int)blockIdx.x);
    { pg8::Gemm g{(const bf16_t*)(a.ws + WS_AO), W + W_AO, T, 1024, 1024}; EpiGate<false, 4> E{MG, P + PC_GA};
      pg8::gemm_phase<EpiGate<false, 4>, pg8::StaticOrder, true, true, 4>(c.lds, c.tid, g, S, E); }
    const int t2 = fresh_tid(c.wid);
    { pg8::Gemm g{(const bf16_t*)(a.ws + WS_YF), W + W_SO, T, 1024, 2048}; EpiGate<true, 4> E{MG, P + PC_GS};
      pg8::gemm_phase<EpiGate<true, 4>, pg8::StaticOrder, true, true, 4>(c.lds, t2, g, S, E); }
}
__device__ __forceinline__ void gres_phase(const Ctx& c, int l, const bf16_t* A, int K, const bf16_t* W, int gate_off, bool fin) {
    CArgs& a = *c.a;
    pg8::Gemm g{A, W, T, 1024, K}; pg8::StaticOrder S; S.init(T, 1024, (int)gridDim.x, (int)blockIdx.x, 192);
    EpiRes<3> E{a.out + O_X, (const float*)(a.ws + WS_MOD) + (size_t)l * 3 * 6144 + gate_off, fin};
    pg8::gemm_phase<EpiRes<3>, pg8::StaticOrder, true, true, 3>(c.lds, c.tid, g, S, E);
}
__device__ __forceinline__ void g4_phase(const Ctx& c, int l) {
    CArgs& a = *c.a;
    pg8::Gemm g{(const bf16_t*)(a.ws + WS_H), (const bf16_t*)(a.ws + WS_W + (size_t)(l & 1) * WS_WSTRIDE) + W_UP, T, UPW, DM};
    pg8::StaticOrder S; S.init(T, UPW, (int)gridDim.x, (int)blockIdx.x);
    EpiStoreBf16 E{(bf16_t*)(a.ws + WS_P), UPW, nullptr, -1};
    pg8::gemm_phase<EpiStoreBf16, pg8::StaticOrder, true, true>(c.lds, c.tid, g, S, E);
}

#define XB_TMO      128
#define XB_XCNT(j)  (256  + 64 * (j))
#define XB_XSUB(j)  (1280 + 64 * (j))
#define XB_XGEN(j)  (2304 + 64 * (j))
#define XB_TOP      3328
#define XB_TOPGEN   3392
#define XCD_BAR_WORDS 3456
#define XB_SPIN_CAP (1u << 18)
__device__ __forceinline__ unsigned xb_ld(unsigned* p)              { return __hip_atomic_load(p, __ATOMIC_RELAXED, __HIP_MEMORY_SCOPE_AGENT); }
__device__ __forceinline__ unsigned xb_add(unsigned* p, unsigned v) { return __hip_atomic_fetch_add(p, v, __ATOMIC_RELAXED, __HIP_MEMORY_SCOPE_AGENT); }
__device__ __forceinline__ unsigned xb_xcc_id() { return (unsigned)__builtin_amdgcn_s_getreg((3 << 11) | 20) & 0xFu; }
#define XB_SPIN(cond, bar) do { unsigned _sp = 0; while (cond) { __builtin_amdgcn_s_sleep(1); \
    if ((++_sp & 255u) == 0u) { if (xb_ld(&(bar)[XB_TMO])) break; if (_sp > XB_SPIN_CAP) { atomicAdd(&(bar)[XB_TMO], 1u); break; } } } } while (0)
struct XcdBarrier { unsigned* bar; unsigned x; volatile LAS unsigned* st; };
__device__ __forceinline__ XcdBarrier xcd_barrier_post(unsigned* bar, volatile LAS unsigned* st) {
    XcdBarrier b; b.bar = bar; b.x = xb_xcc_id(); b.st = st;
    if (threadIdx.x == 0) (void)xb_add(&bar[XB_XCNT(b.x)], 1u);
    return b;
}
__device__ __forceinline__ void xcd_barrier_complete(unsigned* bar, unsigned x, unsigned& nloc, unsigned& nx) {
    const unsigned G = gridDim.x * gridDim.y * gridDim.z;
    unsigned sum, cnt, mine, sp = 0u;
    for (;;) {
        sum = 0u; cnt = 0u; mine = 0u;
#pragma unroll
        for (unsigned j = 0; j < 16; ++j) { const unsigned c = xb_ld(&bar[XB_XCNT(j)]); sum += c; cnt += (c > 0u) ? 1u : 0u; mine = (j == x) ? c : mine; }
        if (sum == G) break;
        __builtin_amdgcn_s_sleep(1);
        if ((++sp & 255u) == 0u) { if (xb_ld(&bar[XB_TMO])) break; if (sp > XB_SPIN_CAP) { atomicAdd(&bar[XB_TMO], 1u); break; } }
    }
    nloc = mine > 0u ? mine : 1u; nx = cnt > 0u ? cnt : 1u;
}
__device__ __forceinline__ void xcd_barrier(const XcdBarrier& b) {
    asm volatile("s_waitcnt vmcnt(0)" ::: "memory");
    __syncthreads();
    if (threadIdx.x == 0) {
        unsigned* bar = b.bar;
        __builtin_amdgcn_s_waitcnt(0);
        unsigned nloc = b.st[0], nx = b.st[1];
        if (nloc == 0u) { xcd_barrier_complete(bar, b.x, nloc, nx); b.st[0] = nloc; b.st[1] = nx; }
        const unsigned old = xb_add(&bar[XB_XSUB(b.x)], 1u);
        const unsigned gen = old / nloc;
        if (old + 1u == (gen + 1u) * nloc) {
            __builtin_amdgcn_fence(__ATOMIC_RELEASE, "agent");
            asm volatile("s_waitcnt vmcnt(0)" ::: "memory");
            const unsigned og = xb_add(&bar[XB_TOP], 1u);
            const unsigned tg = og / nx;
            if (og + 1u == (tg + 1u) * nx) xb_add(&bar[XB_TOPGEN], 1u);
            else XB_SPIN(xb_ld(&bar[XB_TOPGEN]) == tg, bar);
            __builtin_amdgcn_fence(__ATOMIC_ACQUIRE, "agent");
            xb_add(&bar[XB_XGEN(b.x)], 1u);
            asm volatile("s_waitcnt vmcnt(0)" ::: "memory");
        } else {
            XB_SPIN(xb_ld(&bar[XB_XGEN(b.x)]) == gen, bar);
            __builtin_amdgcn_fence(__ATOMIC_ACQUIRE, "agent");
            asm volatile("s_waitcnt vmcnt(0)" ::: "memory");
        }
    }
    __syncthreads();
}

__global__ void __launch_bounds__(512) mega(Args args) {
    extern __shared__ __attribute__((aligned(16))) unsigned char smem[];
    const int ph_lo = args.ph_lo, ph_hi = args.ph_hi, coop = args.coop;
    const int wid0 = __builtin_amdgcn_readfirstlane(threadIdx.x >> 6);
    volatile LAS unsigned* bst = (volatile LAS unsigned*)((LAS unsigned char*)smem + LDS_BYTES - 32);
    if (threadIdx.x < 2) bst[threadIdx.x] = 0u;
    __syncthreads();
    const XcdBarrier xbar = xcd_barrier_post((unsigned*)(args.ws + WS_CTL) + 4096, bst);
    if (ph_lo == 0) {
        Ctx c; c.a = (ArgsP)__builtin_amdgcn_kernarg_segment_ptr(); c.lds = (LAS unsigned char*)smem; c.ldsg = (char*)smem; c.tid = threadIdx.x; c.lane = c.tid & 63; c.wid = __builtin_amdgcn_readfirstlane(c.tid >> 6);
        c.gw = blockIdx.x * 8 + c.wid; c.ngw = gridDim.x * 8;
        setup_phase(c);
        if (1 < ph_hi) { if (coop == 2) cg::this_grid().sync(); else if (coop) xcd_barrier(xbar); }
        __syncthreads();
    }
    for (int ph = (ph_lo < 1 ? 1 : ph_lo); ph < ph_hi; ++ph) {
        const int l = (ph - 1) / NPH_LAYER, sp = (ph - 1) % NPH_LAYER;
        const int nrep = (REP_MASK != 0 && ((REP_MASK >> sp) & 1)) ? 2 : 1;
        for (int r = 0; r < nrep; ++r) {
            const bool fin = (r == nrep - 1);
            Ctx c; { ArgsP ap = (ArgsP)__builtin_amdgcn_kernarg_segment_ptr(); asm volatile("" : "+s"(ap)); c.a = ap; }
            c.lds = (LAS unsigned char*)smem; c.ldsg = (char*)smem;
            c.tid = fresh_tid(wid0);
            c.lane = c.tid & 63; c.wid = wid0;
            c.gw = blockIdx.x * 8 + c.wid; c.ngw = gridDim.x * 8;
            const bf16_t* Wl = (const bf16_t*)(c.a->ws + WS_W + (size_t)(l & 1) * WS_WSTRIDE);
            switch (sp) {
                case 0: modulate_phase(c, l, 0); break;
                case 1: g1_phase(c, l); break;
                case 2: e2_phase(c, l); break;
                case 3: mixer_phase(c, l, r); break;
                case 4: ssd_gate_phase(c, l); break;
                case 5: g2_phase(c, l); break;
                case 6: gres_phase(c, l, (const bf16_t*)(c.a->ws + WS_H), 1024, Wl + W_OUT, 2048, fin); break;
                case 7: modulate_phase(c, l, 1); break;
                case 8: g4_phase(c, l); break;
                case 9: ffn_act_phase(c, l); break;
                default: gres_phase(c, l, (const bf16_t*)(c.a->ws + WS_XBC), DFF, Wl + W_DN, 5120, fin); break;
            }
            if (!fin) { if (coop) xcd_barrier(xbar); __syncthreads(); }
        }
#ifdef EXTRA_SYNC
        for (int es = 0; es < EXTRA_SYNC; ++es) { if (coop) xcd_barrier(xbar); }
#endif
        if (ph + 1 < ph_hi) { if (coop) xcd_barrier(xbar); }
        __syncthreads();
    }
}

extern "C" void kernel_launch(void* const* d_in, const int* in_sizes, int n_in, void* d_out, int out_size, void* d_ws, size_t ws_size, hipStream_t stream) {
    static int grid = 0;
    if (grid == 0) {
        if (n_in != 25 || ws_size < WS_END) { fprintf(stderr, "kernel_launch: unexpected n_in %d or ws_size %zu (< %zu)\n", n_in, ws_size, (size_t)WS_END); grid = -1; return; }
        if (hipFuncSetAttribute((const void*)mega, hipFuncAttributeMaxDynamicSharedMemorySize, LDS_BYTES) != hipSuccess) { fprintf(stderr, "kernel_launch: hipFuncSetAttribute failed\n"); grid = -1; return; }
        int dev = 0, cus = 0, per_cu = 0;
        hipGetDevice(&dev); hipDeviceGetAttribute(&cus, hipDeviceAttributeMultiprocessorCount, dev);
        hipOccupancyMaxActiveBlocksPerMultiprocessor(&per_cu, (const void*)mega, 512, LDS_BYTES);
        if (per_cu < 1) { fprintf(stderr, "kernel_launch: occupancy query says %d blocks/CU\n", per_cu); per_cu = 1; }
        (void)hipGetLastError();
        grid = cus * 1;
    }
    if (grid < 0) return;
    hipMemsetAsync((char*)d_ws + WS_CTL, 0, WS_ROPE, stream);
    Args a{};
    for (int i = 0; i < 25; ++i) a.in[i] = (const float*)d_in[i];
    a.out = (float*)d_out; a.ws = (unsigned char*)d_ws; a.pad = 0;
#if MK_MULTI
    for (int ph = 0; ph < NPH; ++ph) { a.ph_lo = ph; a.ph_hi = ph + 1; a.coop = 0; hipLaunchKernelGGL(mega, dim3(grid), dim3(512), LDS_BYTES, stream, a); }
#else
    a.ph_lo = 0; a.ph_hi = NPH; a.coop = 1;
    void* kargs[] = {&a};
    hipError_t e = hipLaunchCooperativeKernel((const void*)mega, dim3(grid), dim3(512), kargs, LDS_BYTES, stream);
    if (e != hipSuccess) fprintf(stderr, "cooperative launch failed: %s (grid %d)\n", hipGetErrorString(e), grid);
#endif
}
```

```cpp
#include <hip/hip_runtime.h>
#include <hip/hip_cooperative_groups.h>
#include <cstdint>
#include <cstdio>
namespace cg = cooperative_groups;

#ifndef MK_MULTI
#define MK_MULTI 0
#endif

#ifndef REP_MASK
#define REP_MASK 0
#endif
#define LAS __attribute__((address_space(3)))
typedef unsigned short bf16_t;
typedef short bf16x8 __attribute__((ext_vector_type(8)));
typedef short s16x4 __attribute__((ext_vector_type(4)));
typedef float f32x4 __attribute__((ext_vector_type(4)));
typedef float f32x16 __attribute__((ext_vector_type(16)));
typedef unsigned u32x4 __attribute__((ext_vector_type(4)));
typedef unsigned u32x2 __attribute__((ext_vector_type(2)));

constexpr int DM = 1024, NCTX = 16 * 256, NLAT = 2 * 4096, T = NCTX + NLAT;
constexpr int DEPTH = 4, PAST = 256, LKV = PAST + 4096;
constexpr int INW = 8768, PW = 8704, INWP = 8960;
constexpr int DFF = 2816, UPW = 5632, DIN = 2048, XBCW = 3072;
constexpr int PC_Q = 0, PC_K = 1024, PC_V = 1280, PC_Z = 1536, PC_XBC = 3584, PC_GA = 6656, PC_GS = 7680;
constexpr float EPS = 1e-6f;

constexpr size_t MiB = 1u << 20;
constexpr size_t WS_CTL = 0;
constexpr size_t WS_MOD = 1 * MiB;
constexpr size_t WS_ROPE = 1 * MiB + 512 * 1024;
constexpr size_t WS_W = 2 * MiB;
constexpr size_t W_IN = 0, W_AO = (size_t)INWP * 1024, W_SO = W_AO + 1024 * 1024, W_OUT = W_SO + 1024 * 2048, W_UP = W_OUT + 1024 * 1024, W_DN = W_UP + (size_t)UPW * 1024, W_END = W_DN + (size_t)1024 * DFF;
constexpr size_t WS_WSTRIDE = 43 * MiB;
constexpr size_t WS_P = 88 * MiB;
constexpr size_t WS_H = 294 * MiB;
constexpr size_t WS_Q = 318 * MiB;
constexpr size_t WS_AO = WS_Q;
constexpr size_t WS_K = 342 * MiB;
constexpr size_t WS_V = 349 * MiB;
constexpr size_t WS_XBC = 356 * MiB;
constexpr size_t WS_YF = 428 * MiB;
constexpr size_t WS_YB = 476 * MiB;
constexpr size_t WS_DTR = 524 * MiB;
constexpr size_t WS_DTV = 527 * MiB;
constexpr size_t WS_CUM = 530 * MiB;
constexpr size_t WS_END = 533 * MiB;
static_assert(WS_W + 2 * WS_WSTRIDE <= WS_P, "weight buffers");
static_assert(W_END * 2 <= WS_WSTRIDE, "weights");
constexpr size_t O_X = 0, O_CK = (size_t)T * DM, O_CV = O_CK + (size_t)16 * 4 * 256 * 256, O_ST = O_CV + (size_t)16 * 4 * 256 * 256;

constexpr int LDS_BYTES = 147456;
constexpr int NPH_LAYER = 11, NPH = 1 + DEPTH * NPH_LAYER;

struct Args { const float* in[25]; float* out; unsigned char* ws; int ph_lo, ph_hi, coop, pad; };
enum { I_XP = 0, I_XS, I_C, I_CK, I_CV, I_ST, I_CCTX, I_WMOD, I_BMOD, I_WIN, I_QN, I_KN, I_CONVW, I_CONVB, I_DTB, I_ALOG, I_DSKIP, I_SSDN, I_WAO, I_WSO, I_WOUT, I_WUP, I_FCW, I_FCB, I_WDN };

typedef float f32x2_t __attribute__((ext_vector_type(2))); typedef __bf16 bf16x2_t __attribute__((ext_vector_type(2)));
__device__ __forceinline__ unsigned cvtpk(float lo, float hi) { f32x2_t v = {lo, hi}; bf16x2_t b = __builtin_convertvector(v, bf16x2_t); return __builtin_bit_cast(unsigned, b); }
__device__ __forceinline__ float bf2f(unsigned short b) { return __uint_as_float((unsigned)b << 16); }
__device__ __forceinline__ float bflo(unsigned w) { return __uint_as_float(w << 16); }
__device__ __forceinline__ float bfhi(unsigned w) { return __uint_as_float(w & 0xffff0000u); }
__device__ __forceinline__ void unpack8(u32x4 w, float* f) { f[0] = bflo(w.x); f[1] = bfhi(w.x); f[2] = bflo(w.y); f[3] = bfhi(w.y); f[4] = bflo(w.z); f[5] = bfhi(w.z); f[6] = bflo(w.w); f[7] = bfhi(w.w); }
__device__ __forceinline__ u32x4 pack8(const float* f) { u32x4 w; w.x = cvtpk(f[0], f[1]); w.y = cvtpk(f[2], f[3]); w.z = cvtpk(f[4], f[5]); w.w = cvtpk(f[6], f[7]); return w; }
__device__ __forceinline__ u32x4 zero4() { u32x4 z = {0u, 0u, 0u, 0u}; asm volatile("" : "+v"(z)); return z; }
__device__ __forceinline__ float sigmoidf_(float x) { return __builtin_amdgcn_rcpf(1.f + __expf(-x)); }
__device__ __forceinline__ float siluf_(float x) { return x * __builtin_amdgcn_rcpf(1.f + __expf(-x)); }
__device__ __forceinline__ float wave_sum(float v) {
#pragma unroll
    for (int o = 1; o < 64; o <<= 1) v += __shfl_xor(v, o);
    return v;
}
__device__ __forceinline__ int fresh_tid(int wid) { int ln; asm volatile("v_mbcnt_lo_u32_b32 %0, -1, 0\n\tv_mbcnt_hi_u32_b32 %0, -1, %0" : "=v"(ln)); return wid * 64 + ln; }
__device__ __forceinline__ int mod_idx(int t) { return t < NCTX ? 0 : 1 + ((t - NCTX) >> 12); }

namespace gm {
constexpr int BM = 256, BK = 64, HALF = 128, HTB = HALF * BK * 2, NXCD = 8, WGM = 8;
__device__ __forceinline__ int lds_byte(int r, int c) { const int st = (r >> 4) * 2 + (c >> 5), rr = r & 15, cc = c & 31, ob = rr * 64 + cc * 2; return st * 1024 + (ob ^ (((ob >> 9) & 1) << 5)); }
__device__ __forceinline__ void stage_rc(int b, int& R, int& C) { const int st = b / 1024, sb = b % 1024, swz = sb ^ (((sb >> 9) & 1) << 5); R = (st >> 1) * 16 + swz / 64; C = (st & 1) * 32 + (swz % 64) / 2; }
__device__ __forceinline__ void tile_of(int L, int nM, int nN, int& pm, int& pn) {
    const int nwg = nM * nN; int wgid = L;
    { const int q = nwg / NXCD, r = nwg % NXCD, xcd = wgid % NXCD, off = wgid / NXCD; wgid = (xcd < r ? xcd * (q + 1) : r * (q + 1) + (xcd - r) * q) + off; }
    const int nig = WGM * nN, gid = wgid / nig, fm = gid * WGM, gsz = (nM - fm) < WGM ? (nM - fm) : WGM;
    pm = fm + ((wgid % nig) % gsz); pn = (wgid % nig) / gsz;
}
typedef f32x4 Acc[2][2][4][2];
__device__ __forceinline__ void zero_acc(Acc& acc) {
#pragma unroll
    for (int a = 0; a < 2; ++a)
#pragma unroll
        for (int b = 0; b < 2; ++b)
#pragma unroll
            for (int m = 0; m < 4; ++m)
#pragma unroll
                for (int n = 0; n < 2; ++n) acc[a][b][m][n] = (f32x4){0.f, 0.f, 0.f, 0.f};
}
__device__ __forceinline__ void kloop(LAS unsigned char* lds, int tid, const bf16_t* A, int lda, const bf16_t* Bt, int ldb, int K, Acc& acc) {
    const int wid = __builtin_amdgcn_readfirstlane(tid >> 6), lane = tid & 63, wr = wid >> 2, wc = wid & 3, fr = lane & 15, fq = lane >> 4;
    unsigned voffA[2], voffB[2];
#pragma unroll
    for (int i = 0; i < 2; ++i) { int R, C; stage_rc(tid * 16 + i * 8192, R, C); voffA[i] = (unsigned)(R * lda + C) * 2u; voffB[i] = (unsigned)(R * ldb + C) * 2u; }
    const char* cA = (const char*)A; const char* cB = (const char*)Bt;
    const size_t hA = (size_t)HALF * lda * 2, hB = (size_t)HALF * ldb * 2; const size_t ks = BK * 2;
    const unsigned ldsw = (unsigned)wid * 1024u;
    const int aoff = lds_byte(wr * 64 + fr, fq * 8), boff = lds_byte(wc * 32 + fr, fq * 8);
    const int nt = K / BK;
#define SA_(b, h) (((b) * 2 + (h)) * HTB)
#define SB_(b, h) ((4 + (b) * 2 + (h)) * HTB)
#define STAGE(bufoff, gbase, voff) do { _Pragma("unroll") for (int _i = 0; _i < 2; ++_i) \
        __builtin_amdgcn_global_load_lds((const unsigned*)((const char*)(gbase) + (voff)[_i]), (LAS unsigned*)(lds + (bufoff) + ldsw + _i * 8192), 16, 0, 0); } while (0)
#define LDA(dst, b, h) do { _Pragma("unroll") for (int m = 0; m < 4; ++m) _Pragma("unroll") for (int k = 0; k < 2; ++k) dst[m][k] = *(const LAS bf16x8*)(lds + SA_(b, h) + aoff + m * 2048 + k * 1024); } while (0)
#define LDB(dst, b, h) do { _Pragma("unroll") for (int n = 0; n < 2; ++n) _Pragma("unroll") for (int k = 0; k < 2; ++k) dst[n][k] = *(const LAS bf16x8*)(lds + SB_(b, h) + boff + n * 2048 + k * 1024); } while (0)
#define MMA(ai, bj, At, Bt_) do { __builtin_amdgcn_s_setprio(1); _Pragma("unroll") for (int m = 0; m < 4; ++m) _Pragma("unroll") for (int n = 0; n < 2; ++n) _Pragma("unroll") for (int k = 0; k < 2; ++k) \
        acc[ai][bj][m][n] = __builtin_amdgcn_mfma_f32_16x16x32_bf16(Bt_[n][k], At[m][k], acc[ai][bj][m][n], 0, 0, 0); __builtin_amdgcn_s_setprio(0); } while (0)
#define WAIT_V(n) asm volatile("s_waitcnt vmcnt(" #n ")" ::: "memory")
#define WAIT_L(n) asm volatile("s_waitcnt lgkmcnt(" #n ")" ::: "memory")
#define BAR __builtin_amdgcn_s_barrier()
#define SCHED __builtin_amdgcn_sched_barrier(0)
    bf16x8 At[4][2], B0[2][2], B1[2][2];
    STAGE(SB_(0, 0), cB, voffB); STAGE(SA_(0, 0), cA, voffA); STAGE(SB_(0, 1), cB + hB, voffB); STAGE(SA_(0, 1), cA + hA, voffA);
    if (wr == 1) BAR;
    WAIT_V(4); BAR;
    STAGE(SB_(1, 0), cB + ks, voffB); STAGE(SA_(1, 0), cA + ks, voffA); STAGE(SB_(1, 1), cB + hB + ks, voffB);
    WAIT_V(6); BAR;
    for (int t = 0; t < nt - 2; t += 2) {
        const char* a1 = cA + (size_t)(t + 1) * ks; const char* a2 = cA + (size_t)(t + 2) * ks; const char* b2 = cB + (size_t)(t + 2) * ks;
        const char* a3 = a2 + ks; const char* b3 = b2 + ks;
        LDB(B0, 0, 0); SCHED; LDA(At, 0, 0); STAGE(SA_(1, 1), a1 + hA, voffA);
        WAIT_L(8); BAR; WAIT_L(0); MMA(0, 0, At, B0); BAR; SCHED;
        LDB(B1, 0, 1); STAGE(SB_(0, 0), b2, voffB);
        BAR; WAIT_L(0); MMA(0, 1, At, B1); BAR;
        LDA(At, 0, 1); STAGE(SA_(0, 0), a2, voffA);
        BAR; WAIT_L(0); MMA(1, 0, At, B0); BAR; SCHED;
        STAGE(SB_(0, 1), b2 + hB, voffB);
        WAIT_V(6); BAR; MMA(1, 1, At, B1); BAR;
        LDB(B0, 1, 0); SCHED; LDA(At, 1, 0); STAGE(SA_(0, 1), a2 + hA, voffA);
        WAIT_L(8); BAR; WAIT_L(0); MMA(0, 0, At, B0); BAR; SCHED;
        LDB(B1, 1, 1); STAGE(SB_(1, 0), b3, voffB);
        BAR; WAIT_L(0); MMA(0, 1, At, B1); BAR;
        LDA(At, 1, 1); STAGE(SA_(1, 0), a3, voffA);
        BAR; WAIT_L(0); MMA(1, 0, At, B0); BAR; SCHED;
        STAGE(SB_(1, 1), b3 + hB, voffB);
        WAIT_V(6); BAR; MMA(1, 1, At, B1); BAR;
    }
    { const char* a1 = cA + (size_t)(nt - 1) * ks;
      LDB(B0, 0, 0); LDA(At, 0, 0); STAGE(SA_(1, 1), a1 + hA, voffA);
      BAR; WAIT_L(0); MMA(0, 0, At, B0); BAR;
      LDB(B1, 0, 1); BAR; WAIT_L(0); MMA(0, 1, At, B1); BAR;
      LDA(At, 0, 1); WAIT_V(4); BAR; WAIT_L(0); MMA(1, 0, At, B0); MMA(1, 1, At, B1); BAR; }
    { LDB(B0, 1, 0); LDA(At, 1, 0); WAIT_V(2); BAR; WAIT_L(0); MMA(0, 0, At, B0); BAR;
      LDB(B1, 1, 1); WAIT_V(0); BAR; WAIT_L(0); MMA(0, 1, At, B1); BAR;
      LDA(At, 1, 1); BAR; WAIT_L(0); MMA(1, 0, At, B0); MMA(1, 1, At, B1); BAR; }
    if (wr == 0) BAR;
#undef SA_
#undef SB_
#undef STAGE
#undef LDA
#undef LDB
#undef MMA
#undef WAIT_V
#undef WAIT_L
#undef BAR
#undef SCHED
}
template <class F> __device__ __forceinline__ void for_acc(Acc& acc, int tid, int brow, int bcol, F f) {
    const int wid = tid >> 6, lane = tid & 63, wr = wid >> 2, wc = wid & 3, fr = lane & 15, fq = lane >> 4;
#pragma unroll
    for (int ai = 0; ai < 2; ++ai)
#pragma unroll
        for (int m = 0; m < 4; ++m) {
            const int row = brow + ai * HALF + wr * 64 + m * 16 + fr;
#pragma unroll
            for (int bj = 0; bj < 2; ++bj)
#pragma unroll
                for (int n = 0; n < 2; ++n) f(row, bcol + bj * HALF + wc * 32 + n * 16 + fq * 4, acc[ai][bj][m][n]);
            asm volatile("" ::: "memory");
        }
}
}

namespace at {
constexpr int D = 128, NW = 8, QBLK = 32, KVBLK = 64;
constexpr float SCALE = 0.088388347648318440f, THR = 8.f;
constexpr int LDQ = 1024, LDK = 256, LDO = 1024;
constexpr int SHM_V = KVBLK * D * 2, SHM_K = KVBLK * D * 2, SHM_ATTN = 2 * SHM_V + 2 * SHM_K + NW * 64 * 4;
#define KSWZ(row, colB) ((row) * 256 + ((colB) ^ (((row) & 7) << 4)))
#define SBAR() __builtin_amdgcn_sched_barrier(0)
__device__ __forceinline__ int crow(int r, int hi) { return (r & 3) + 8 * (r >> 2) + 4 * hi; }
__device__ __forceinline__ void partialSM(f32x16& p0, f32x16& p1, float& m_reg, float& mn, float& alpha) {
    constexpr float C = SCALE * 1.4426950408889634f;
    float pmax = p0[0];
#pragma unroll
    for (int r = 1; r < 16; ++r) pmax = fmaxf(pmax, p0[r]);
#pragma unroll
    for (int r = 0; r < 16; ++r) pmax = fmaxf(pmax, p1[r]);
    { auto rr = __builtin_amdgcn_permlane32_swap(__float_as_uint(pmax), __float_as_uint(pmax), false, false);
      pmax = fmaxf(__uint_as_float(rr[0]), __uint_as_float(rr[1])); }
    if (__builtin_expect(__all(pmax - m_reg <= THR / SCALE), 1)) { mn = m_reg; alpha = 1.f; }
    else { mn = fmaxf(m_reg, pmax); alpha = __builtin_amdgcn_exp2f((m_reg - mn) * C); m_reg = mn; }
    float mnC = -mn * C;
#pragma unroll
    for (int r = 0; r < 16; ++r) p0[r] = fmaf(p0[r], C, mnC);
#pragma unroll
    for (int r = 0; r < 16; ++r) p1[r] = fmaf(p1[r], C, mnC);
#pragma unroll
    for (int r = 0; r < 16; ++r) p0[r] = __builtin_amdgcn_exp2f(p0[r]);
}
__device__ __forceinline__ void finishSM(f32x16& p0, f32x16& p1, float alpha, float& l_reg, bf16x8& pa0, bf16x8& pa1, bf16x8& pa2, bf16x8& pa3) {
#pragma unroll
    for (int r = 0; r < 16; ++r) p1[r] = __builtin_amdgcn_exp2f(p1[r]);
    float ps = 0;
#pragma unroll
    for (int r = 0; r < 16; ++r) ps += p0[r];
#pragma unroll
    for (int r = 0; r < 16; ++r) ps += p1[r];
    { auto rr = __builtin_amdgcn_permlane32_swap(__float_as_uint(ps), __float_as_uint(ps), false, false);
      ps = __uint_as_float(rr[0]) + __uint_as_float(rr[1]); }
    l_reg = l_reg * alpha + ps;
#define PK4(P, BASE, OUT) do { unsigned a0 = cvtpk(P[BASE + 0], P[BASE + 1]), a1 = cvtpk(P[BASE + 2], P[BASE + 3]);   \
    unsigned b0 = cvtpk(P[BASE + 4], P[BASE + 5]), b1 = cvtpk(P[BASE + 6], P[BASE + 7]);                              \
    auto r0 = __builtin_amdgcn_permlane32_swap(a0, b0, false, false); auto r1 = __builtin_amdgcn_permlane32_swap(a1, b1, false, false); \
    u32x4 w = {r0[0], r1[0], r0[1], r1[1]}; OUT = *reinterpret_cast<bf16x8*>(&w); } while (0)
    PK4(p0, 0, pa0); PK4(p0, 8, pa1); PK4(p1, 0, pa2); PK4(p1, 8, pa3);
#undef PK4
}
__device__ __forceinline__ void qkt(f32x16& p0, f32x16& p1, const bf16_t* Ks, const bf16x8* qr, int r32, int hi) {
    p0 = f32x16{}; p1 = f32x16{};
#pragma unroll
    for (int d0 = 0; d0 < 8; ++d0) { int cb = (d0 * 16 + hi * 8) * 2;
        bf16x8 b0 = *reinterpret_cast<const bf16x8*>((const char*)Ks + KSWZ(r32, cb));
        bf16x8 b1 = *reinterpret_cast<const bf16x8*>((const char*)Ks + KSWZ(32 + r32, cb));
        p0 = __builtin_amdgcn_mfma_f32_32x32x16_bf16(b0, qr[d0], p0, 0, 0, 0);
        p1 = __builtin_amdgcn_mfma_f32_32x32x16_bf16(b1, qr[d0], p1, 0, 0, 0); }
}
__device__ __forceinline__ int v_st(int k, int c) { const int kk = (k & ~0xC) | ((k & 4) << 1) | ((k & 8) >> 1); return ((kk >> 3) * 4 + (c >> 5)) * 512 + ((kk & 7) * 32 + (c & 31)) * 2; }
__device__ __forceinline__ int v_rd_base(int lane) { return ((lane & 3) << 3) | (((lane >> 2) & 3) << 6) | (((lane >> 4) & 1) << 5) | (((lane >> 5) & 1) << 8); }
constexpr int v_rd_off(int d0, int ks, int half) { return d0 * 512 + ks * 4096 + half * 2048; }
template <int OFF> __device__ __forceinline__ s16x4 tr_read(int vb) {
    s16x4 r; asm volatile("ds_read_b64_tr_b16 %0, %1 offset:%2" : "=&v"(r) : "v"(vb), "i"(OFF) : "memory"); return r;
}
template <int D0> __device__ __forceinline__ void pv_one(f32x16& od, int vb, bf16x8 pa0, bf16x8 pa1, bf16x8 pa2, bf16x8 pa3) {
    const s16x4 l0 = tr_read<v_rd_off(D0, 0, 0)>(vb), h0 = tr_read<v_rd_off(D0, 0, 1)>(vb), l1 = tr_read<v_rd_off(D0, 1, 0)>(vb), h1 = tr_read<v_rd_off(D0, 1, 1)>(vb);
    const s16x4 l2 = tr_read<v_rd_off(D0, 2, 0)>(vb), h2 = tr_read<v_rd_off(D0, 2, 1)>(vb), l3 = tr_read<v_rd_off(D0, 3, 0)>(vb), h3 = tr_read<v_rd_off(D0, 3, 1)>(vb);
    asm volatile("s_waitcnt lgkmcnt(0)" ::: "memory"); SBAR();
#define PK(L, H) (bf16x8){L[0], L[1], L[2], L[3], H[0], H[1], H[2], H[3]}
    od = __builtin_amdgcn_mfma_f32_32x32x16_bf16(pa0, PK(l0, h0), od, 0, 0, 0);
    od = __builtin_amdgcn_mfma_f32_32x32x16_bf16(pa1, PK(l1, h1), od, 0, 0, 0);
    od = __builtin_amdgcn_mfma_f32_32x32x16_bf16(pa2, PK(l2, h2), od, 0, 0, 0);
    od = __builtin_amdgcn_mfma_f32_32x32x16_bf16(pa3, PK(l3, h3), od, 0, 0, 0);
#undef PK
}
__device__ __forceinline__ void pv_d0(f32x16* o, int vb, bf16x8 pa0, bf16x8 pa1, bf16x8 pa2, bf16x8 pa3) {
    pv_one<0>(o[0], vb, pa0, pa1, pa2, pa3); pv_one<1>(o[1], vb, pa0, pa1, pa2, pa3); pv_one<2>(o[2], vb, pa0, pa1, pa2, pa3); pv_one<3>(o[3], vb, pa0, pa1, pa2, pa3);
}
__device__ __forceinline__ void attn_body(const bf16_t* __restrict__ Qb, const bf16_t* __restrict__ Kh, const bf16_t* __restrict__ Vh, bf16_t* __restrict__ Ob, int seq, char* lds, int tid) {
    const int wid = tid >> 6, lane = tid & 63, r32 = lane & 31, hi = lane >> 5;
    bf16_t* V_lds = (bf16_t*)lds; bf16_t* K_lds = (bf16_t*)(lds + 2 * SHM_V);
    float* ws = (float*)(lds + 2 * SHM_V + 2 * SHM_K) + wid * 64; float* li_l = ws; float* al_l = ws + 32;
    float m_reg = -1e30f, l_reg = 0; f32x16 o[4] = {}; bf16x8 qr[8];
    const bf16_t* Qw = Qb + (long)(wid * QBLK + r32) * LDQ + hi * 8;
#pragma unroll
    for (int d0 = 0; d0 < 8; ++d0) qr[d0] = *reinterpret_cast<const bf16x8*>(Qw + d0 * 16);
    const int sr = tid >> 4, sc = (tid & 15) * 8, vst0 = v_st(sr, sc), vst1 = v_st(32 + sr, sc);
    const int vb0 = (int)(uintptr_t)V_lds + v_rd_base(lane);
    struct { bf16x8 vs0, vs1, ks0, ks1; } sr_[2];
#define SLOAD(i, k0) do { sr_[i].vs0 = *(const bf16x8*)(&Vh[(long)((k0) + sr) * LDK + sc]); sr_[i].vs1 = *(const bf16x8*)(&Vh[(long)((k0) + 32 + sr) * LDK + sc]); \
    sr_[i].ks0 = *(const bf16x8*)(&Kh[(long)((k0) + sr) * LDK + sc]); sr_[i].ks1 = *(const bf16x8*)(&Kh[(long)((k0) + 32 + sr) * LDK + sc]); } while (0)
#define SWRITE(b, i) do { *(bf16x8*)((char*)V_lds + (b) * SHM_V + vst0) = sr_[i].vs0;          \
    *(bf16x8*)((char*)V_lds + (b) * SHM_V + vst1) = sr_[i].vs1; int kc = sc * 2;               \
    *(bf16x8*)((char*)K_lds + (b) * SHM_K + KSWZ(sr, kc)) = sr_[i].ks0;                       \
    *(bf16x8*)((char*)K_lds + (b) * SHM_K + KSWZ(32 + sr, kc)) = sr_[i].ks1; } while (0)
#define SWAIT() asm volatile("s_waitcnt vmcnt(4)" ::: "memory")
#define RESC(a) do { if (__any((a) < 1.f)) { if (hi == 0) al_l[r32] = (a); asm volatile("s_waitcnt lgkmcnt(0)" ::: "memory"); \
    _Pragma("unroll") for (int d = 0; d < 4; ++d) _Pragma("unroll") for (int r = 0; r < 16; ++r) o[d][r] *= al_l[crow(r, hi)]; } } while (0)
    f32x16 pA0, pA1, pB0, pB1; float mnA, mnB, alA, alB; bf16x8 pa0, pa1, pa2, pa3; const int NT = seq / KVBLK;
    constexpr int SE = 0, SO = 1;
    SLOAD(SE, 0); asm volatile("s_waitcnt vmcnt(0)" ::: "memory"); SWRITE(0, SE); __syncthreads();
    qkt(pA0, pA1, K_lds, qr, r32, hi); partialSM(pA0, pA1, m_reg, mnA, alA);
    SLOAD(SO, KVBLK); if (2 < NT) SLOAD(SE, 2 * KVBLK);
    SWAIT(); SWRITE(1, SO); __syncthreads();
    for (int j = 1; j + 1 < NT; j += 2) {
        SBAR(); qkt(pB0, pB1, (bf16_t*)((char*)K_lds + SHM_K), qr, r32, hi);
        finishSM(pA0, pA1, alA, l_reg, pa0, pa1, pa2, pa3); SBAR();
        SLOAD(SO, (j + 2) * KVBLK); SBAR();
        pv_d0(o, vb0, pa0, pa1, pa2, pa3); partialSM(pB0, pB1, m_reg, mnB, alB);
        __syncthreads(); SWAIT(); SWRITE(0, SE);
        RESC(alB); __syncthreads();
        SBAR(); qkt(pA0, pA1, K_lds, qr, r32, hi);
        finishSM(pB0, pB1, alB, l_reg, pa0, pa1, pa2, pa3); SBAR();
        if (j + 3 < NT) SLOAD(SE, (j + 3) * KVBLK); SBAR();
        pv_d0(o, vb0 + (int)SHM_V, pa0, pa1, pa2, pa3); partialSM(pA0, pA1, m_reg, mnA, alA);
        __syncthreads(); SWAIT(); SWRITE(1, SO);
        RESC(alA); __syncthreads();
    }
    SBAR(); qkt(pB0, pB1, (bf16_t*)((char*)K_lds + SHM_K), qr, r32, hi);
    finishSM(pA0, pA1, alA, l_reg, pa0, pa1, pa2, pa3); SBAR();
    pv_d0(o, vb0, pa0, pa1, pa2, pa3); partialSM(pB0, pB1, m_reg, mnB, alB);
    __syncthreads(); RESC(alB);
    finishSM(pB0, pB1, alB, l_reg, pa0, pa1, pa2, pa3); SBAR();
    pv_d0(o, vb0 + (int)SHM_V, pa0, pa1, pa2, pa3);
    if (hi == 0) li_l[r32] = l_reg; asm volatile("s_waitcnt lgkmcnt(0)" ::: "memory");
    float rli[16];
#pragma unroll
    for (int r = 0; r < 16; ++r) rli[r] = __builtin_amdgcn_rcpf(li_l[crow(r, hi)]);
    bf16_t* Ow = Ob + (long)(wid * QBLK) * LDO;
#pragma unroll
    for (int r = 0; r < 16; ++r) { int orow = crow(r, hi);
#pragma unroll
        for (int d0 = 0; d0 < 4; ++d0) Ow[(long)orow * LDO + d0 * 32 + r32] = (bf16_t)(cvtpk(o[d0][r] * rli[r], 0.f) & 0xffffu); }
    __syncthreads();
#undef SLOAD
#undef SWRITE
#undef SWAIT
#undef RESC
}
#undef KSWZ
#undef SBAR
}

typedef __attribute__((address_space(4))) const Args CArgs;
typedef CArgs* ArgsP;
struct Ctx {
    ArgsP a; LAS unsigned char* lds; char* ldsg; int tid, lane, wid, gw, ngw;
};

__device__ __forceinline__ unsigned f2bf(float f) { unsigned u = __float_as_uint(f); return (u + 0x7fffu + ((u >> 16) & 1u)) >> 16; }
__device__ __forceinline__ unsigned pk2(float lo, float hi) { return f2bf(lo) | (f2bf(hi) << 16); }
__device__ __forceinline__ void transpose_item(const float* W, int K, int N, bf16_t* WT, LAS float* scr, int item, int lane, bool remap) {
    const int nblk = N / 32, kb = item / nblk, nb = item % nblk, k0 = 64 * kb, n0 = 32 * nb;
    int r0 = n0;
    if (remap) r0 = (n0 < 6656) ? n0 : (n0 < 6720 ? n0 - 6656 + 8704 : n0 - 64);
    float tv[32];
#pragma unroll
    for (int i = 0; i < 32; ++i) { const int kk = 2 * i + (lane >> 5); tv[i] = W[(size_t)(k0 + kk) * N + n0 + (lane & 31)]; }
#pragma unroll
    for (int i = 0; i < 32; ++i) { const int kk = 2 * i + (lane >> 5); scr[kk * 33 + (lane & 31)] = tv[i]; }
    asm volatile("s_waitcnt lgkmcnt(0)" ::: "memory");
    const int c = lane & 7;
#pragma unroll
    for (int j = 0; j < 4; ++j) { const int n = (lane >> 3) + 8 * j; const LAS float* s = scr + (8 * c) * 33 + n;
        u32x4 o; o.x = pk2(s[0 * 33], s[1 * 33]); o.y = pk2(s[2 * 33], s[3 * 33]); o.z = pk2(s[4 * 33], s[5 * 33]); o.w = pk2(s[6 * 33], s[7 * 33]);
        *(u32x4*)(WT + (size_t)(r0 + n) * K + k0 + 8 * c) = o; }
    asm volatile("s_waitcnt lgkmcnt(0)" ::: "memory");
}
__device__ __forceinline__ void convert_weights(const Ctx& c, int l, int gw, int ngw) {
    CArgs& a = *c.a; bf16_t* W = (bf16_t*)(a.ws + WS_W + (size_t)(l & 1) * WS_WSTRIDE);
    LAS float* scr = (LAS float*)(c.lds + c.wid * 16384);
    constexpr int I_IN = 16 * (INW / 32), I_AO = 16 * 32, I_SO = 32 * 32, I_OUT = 16 * 32, I_UP = 16 * (UPW / 32), I_DN = (DFF / 64) * 32;
    constexpr int NIT = I_IN + I_AO + I_SO + I_OUT + I_UP + I_DN;
    for (int it = gw; it < NIT; it += ngw) {
        int r = it;
        if (r < I_IN) { transpose_item(a.in[I_WIN] + (size_t)l * 1024 * INW, 1024, INW, W + W_IN, scr, r, c.lane, true); continue; } r -= I_IN;
        if (r < I_AO) { transpose_item(a.in[I_WAO] + (size_t)l * 1024 * 1024, 1024, 1024, W + W_AO, scr, r, c.lane, false); continue; } r -= I_AO;
        if (r < I_SO) { transpose_item(a.in[I_WSO] + (size_t)l * 2048 * 1024, 2048, 1024, W + W_SO, scr, r, c.lane, false); continue; } r -= I_SO;
        if (r < I_OUT) { transpose_item(a.in[I_WOUT] + (size_t)l * 1024 * 1024, 1024, 1024, W + W_OUT, scr, r, c.lane, false); continue; } r -= I_OUT;
        if (r < I_UP) { transpose_item(a.in[I_WUP] + (size_t)l * 1024 * UPW, 1024, UPW, W + W_UP, scr, r, c.lane, false); continue; } r -= I_UP;
        transpose_item(a.in[I_WDN] + (size_t)l * DFF * 1024, DFF, 1024, W + W_DN, scr, r, c.lane, false);
    }
    for (int i = gw * 64 + c.lane; i < 192 * 1024 / 8; i += ngw * 64) *(u32x4*)(W + W_IN + (size_t)8768 * 1024 + (size_t)i * 8) = zero4();
}

__device__ __forceinline__ void modulate_phase(const Ctx& c, int l, int which) {
    CArgs& a = *c.a; const float* x = a.out + O_X; bf16_t* H = (bf16_t*)(a.ws + WS_H);
    const float* modl = (const float*)(a.ws + WS_MOD) + (size_t)l * 3 * 6144;
    for (int t = c.gw; t < T; t += c.ngw) {
        const float* md = modl + mod_idx(t) * 6144 + which * 3072; const float* sh = md; const float* sc = md + 1024;
        const f32x4* xr = (const f32x4*)(x + (size_t)t * DM);
        f32x4 v[4]; float s = 0.f;
#pragma unroll
        for (int j = 0; j < 4; ++j) { v[j] = xr[c.lane + 64 * j]; s += v[j].x * v[j].x + v[j].y * v[j].y + v[j].z * v[j].z + v[j].w * v[j].w; }
        const float rstd = rsqrtf(wave_sum(s) * (1.f / DM) + EPS);
#pragma unroll
        for (int j = 0; j < 4; ++j) { const int col = (c.lane + 64 * j) * 4; const f32x4 scv = *(const f32x4*)(sc + col), shv = *(const f32x4*)(sh + col);
            const f32x4 o = v[j] * rstd * (scv + 1.f) + shv; u32x2 w; w.x = cvtpk(o.x, o.y); w.y = cvtpk(o.z, o.w);
            *(u32x2*)(H + (size_t)t * DM + col) = w; }
    }
}

__device__ __forceinline__ void setup_phase(const Ctx& c) {
    CArgs& a = *c.a;
    { const int g = blockIdx.x * 512 + c.tid;
      if (g < 2048) { const int pos = g >> 5, i = g & 31; const float inv = __builtin_amdgcn_exp2f(-(float)i * (13.287712379549449f / 32.0f)); const float ang = (float)pos * inv;
          float* rt = (float*)(a.ws + WS_ROPE); rt[g] = __cosf(ang); rt[2048 + g] = __sinf(ang); } }
    LAS float* sl = (LAS float*)c.lds; LAS float* red = (LAS float*)(c.lds + 12288);
    for (int i = c.tid; i < 3072; i += 512) { const int s = i >> 10, k = i & 1023; const float cv = s == 0 ? a.in[I_CCTX][k] : a.in[I_C][(s - 1) * 1024 + k]; sl[i] = siluf_(cv); }
    __syncthreads();
    float* mod = (float*)(a.ws + WS_MOD);
    for (int item = blockIdx.x; item < 192; item += gridDim.x) {
        const int l = item / 48, cb = (item % 48) >> 1, kh = item & 1, col = cb * 256 + c.lane * 4, k0 = kh * 512 + c.wid * 64;
        f32x4 acc[3] = {{0.f, 0.f, 0.f, 0.f}, {0.f, 0.f, 0.f, 0.f}, {0.f, 0.f, 0.f, 0.f}};
        const float* wp = a.in[I_WMOD] + ((size_t)l * 1024 + k0) * 6144 + col;
#pragma unroll 16
        for (int k = 0; k < 64; ++k) { const f32x4 w = *(const f32x4*)(wp + (size_t)k * 6144);
            acc[0] += w * sl[k0 + k]; acc[1] += w * sl[1024 + k0 + k]; acc[2] += w * sl[2048 + k0 + k]; }
#pragma unroll
        for (int s = 0; s < 3; ++s) *(LAS f32x4*)(red + (c.wid * 3 + s) * 256 + c.lane * 4) = acc[s];
        __syncthreads();
        for (int e = c.tid; e < 768; e += 512) { const int s = e >> 8, cc = e & 255; float v = kh == 0 ? a.in[I_BMOD][(size_t)l * 6144 + cb * 256 + cc] : 0.f;
#pragma unroll
            for (int w = 0; w < 8; ++w) v += red[(w * 3 + s) * 256 + cc];
            atomicAdd(&mod[((size_t)l * 3 + s) * 6144 + cb * 256 + cc], v); }
        __syncthreads();
    }
    { const f32x4* xp = (const f32x4*)a.in[I_XP]; const f32x4* xs = (const f32x4*)a.in[I_XS]; f32x4* o = (f32x4*)(a.out + O_X);
      const size_t n1 = (size_t)NCTX * DM / 4, n = (size_t)T * DM / 4, st = (size_t)gridDim.x * 512;
      for (size_t i = (size_t)blockIdx.x * 512 + c.tid; i < n; i += 4 * st) {
          f32x4 v[4];
#pragma unroll
          for (int u = 0; u < 4; ++u) { const size_t j = i + u * st; if (j < n) v[u] = j < n1 ? xp[j] : xs[j - n1]; }
#pragma unroll
          for (int u = 0; u < 4; ++u) { const size_t j = i + u * st; if (j < n) o[j] = v[u]; } } }
    convert_weights(c, 0, c.gw, c.ngw);
}

__device__ __forceinline__ void e2_phase(const Ctx& c, int l) {
    CArgs& a = *c.a;
    const bf16_t* P = (const bf16_t*)(a.ws + WS_P); bf16_t* Q = (bf16_t*)(a.ws + WS_Q); bf16_t* KB = (bf16_t*)(a.ws + WS_K); bf16_t* VB = (bf16_t*)(a.ws + WS_V);
    bf16_t* XB = (bf16_t*)(a.ws + WS_XBC);
    const float* rt = (const float*)(a.ws + WS_ROPE);
    const int lane = c.lane;
    constexpr int NT_DT = 96 * 16, NT_CACHE = 512, NRUN = T / 32, NT_TOK = NRUN * 9;
    for (int id = c.gw; id < NT_DT + NT_CACHE + NT_TOK; id += c.ngw) {
        if (id < NT_DT) {
            const int chk = id >> 4, col = (id & 15) * 4 + (lane >> 4), rg = lane & 15, dir = col >> 5, row0 = chk * 128;
            const float bias = a.in[I_DTB][l * 64 + col], av = -__expf(a.in[I_ALOG][l * 64 + col]);
            const float* dr = (const float*)(a.ws + WS_DTR); float* dv = (float*)(a.ws + WS_DTV); float* cm = (float*)(a.ws + WS_CUM);
            float d[8], cs[8];
#pragma unroll
            for (int e = 0; e < 8; ++e) { const int i = rg * 8 + e, row = row0 + (dir ? 127 - i : i); d[e] = dr[(size_t)row * 64 + col] + bias; }
            float run = 0.f;
#pragma unroll
            for (int e = 0; e < 8; ++e) { const float xr = d[e]; d[e] = xr > 20.f ? xr : log1pf(__expf(xr)); run += d[e] * av; cs[e] = run; }
            float inc = run;
#pragma unroll
            for (int o = 1; o < 16; o <<= 1) { const float t = __shfl_up(inc, o, 16); if (rg >= o) inc += t; }
            const float off = inc - run;
#pragma unroll
            for (int e = 0; e < 8; ++e) { const int i = rg * 8 + e, row = row0 + (dir ? 127 - i : i); dv[(size_t)row * 64 + col] = d[e]; cm[(size_t)row * 64 + col] = cs[e] + off; }
            continue;
        }
        if (id < NT_DT + NT_CACHE) {
            const int r = id - NT_DT, b = r >> 8, j = r & 255; const bool isv = lane >= 32; const int li = lane & 31;
            const float* src = a.in[isv ? I_CV : I_CK] + (((size_t)b * DEPTH + l) * PAST + j) * 256 + li * 8;
            const f32x4 v0 = *(const f32x4*)src, v1 = *(const f32x4*)(src + 4);
            u32x4 w; w.x = cvtpk(v0.x, v0.y); w.y = cvtpk(v0.z, v0.w); w.z = cvtpk(v1.x, v1.y); w.w = cvtpk(v1.z, v1.w);
            *(u32x4*)((isv ? VB : KB) + (size_t)(NCTX + b * LKV + j) * 256 + li * 8) = w;
            continue;
        }
        const int id2 = id - NT_DT - NT_CACHE;
        if (id2 < NRUN * 6) {
            const int run = id2 / 6, wt = id2 % 6, t0 = run * 32, c0 = (wt * 64 + lane) * 8;
            const bool lat = t0 >= NCTX; const int tt = lat ? t0 - NCTX : t0; const int pos0 = lat ? tt & 4095 : tt & 255, L = lat ? 4096 : 256;
            const float* cw = a.in[I_CONVW] + (size_t)l * 3 * XBCW + c0; const float* cbp = a.in[I_CONVB] + (size_t)l * XBCW + c0;
            float w0[8], w1[8], w2[8], bs[8];
#pragma unroll
            for (int e = 0; e < 8; ++e) { w0[e] = cw[e]; w1[e] = cw[XBCW + e]; w2[e] = cw[2 * XBCW + e]; bs[e] = cbp[e]; }
            const bf16_t* base = P + (size_t)t0 * PW + PC_XBC + c0; bf16_t* ob = XB + (size_t)t0 * XBCW + c0;
            const u32x4 zz = zero4();
            const bool tail_ok = pos0 + 32 < L;
            u32x4 R[10], N[8];
            R[0] = pos0 > 0 ? *(const u32x4*)(base - PW) : zz; R[1] = *(const u32x4*)base;
#pragma unroll
            for (int j = 0; j < 8; ++j) R[2 + j] = *(const u32x4*)(base + (size_t)(1 + j) * PW);
            for (int blk = 0; blk < 4; ++blk) {
                const int i0 = blk * 8;
                if (blk < 3) {
#pragma unroll
                    for (int j = 0; j < 8; ++j) { const int idx = i0 + 9 + j; N[j] = (idx < 32 || tail_ok) ? *(const u32x4*)(base + (size_t)idx * PW) : zz; }
                }
#pragma unroll
                for (int j = 0; j < 8; ++j) {
                    float xa[8], xb[8], xc[8], o[8]; unpack8(R[j], xa); unpack8(R[j + 1], xb); unpack8(R[j + 2], xc);
#pragma unroll
                    for (int e = 0; e < 8; ++e) o[e] = siluf_(bs[e] + w0[e] * xa[e] + w1[e] * xb[e] + w2[e] * xc[e]);
                    *(u32x4*)(ob + (size_t)(i0 + j) * XBCW) = pack8(o);
                }
                R[0] = R[8]; R[1] = R[9];
#pragma unroll
                for (int j = 0; j < 8; ++j) R[2 + j] = N[j];
            }
            continue;
        }
        const int id3 = id2 - NRUN * 6, run = id3 / 3, sub = id3 % 3, t0 = run * 32;
        const bool lat = t0 >= NCTX; const int tt0 = lat ? t0 - NCTX : t0; const int sb = lat ? tt0 >> 12 : tt0 >> 8, pos0 = lat ? tt0 & 4095 : tt0 & 255;
        const int li = lane & 15, d0 = li * 8; const int hq = sub * 4 + (lane >> 4);
        const bool isq = sub < 2, isv = !isq && lane >= 32; const int kvh = (lane >> 4) & 1;
        const int scol = isq ? PC_Q + hq * 128 + d0 : (isv ? PC_V : PC_K) + kvh * 128 + d0;
        float nwv[8];
        { const float* nw = a.in[isq ? I_QN : I_KN] + l * 128 + d0;
#pragma unroll
          for (int e = 0; e < 8; ++e) nwv[e] = nw[e]; }
        const bool first = (li & 7) < 4; const int fi = ((li & 3) * 8);
        const bf16_t* src0 = P + (size_t)t0 * PW + scol;
        for (int blk = 0; blk < 4; ++blk) {
        u32x4 RR[8];
#pragma unroll
        for (int j = 0; j < 8; ++j) RR[j] = *(const u32x4*)(src0 + (size_t)(blk * 8 + j) * PW);
#pragma unroll
        for (int j = 0; j < 8; ++j) {
            const int i = blk * 8 + j; const u32x4 cur = RR[j];
            const int t = t0 + i, pos = pos0 + i;
            float xv[8]; unpack8(cur, xv);
            float ss = 0.f;
#pragma unroll
            for (int e = 0; e < 8; ++e) ss += xv[e] * xv[e];
            ss += __shfl_xor(ss, 1); ss += __shfl_xor(ss, 2); ss += __shfl_xor(ss, 4); ss += __shfl_xor(ss, 8);
            const float rstd = rsqrtf(ss * (1.f / 128.f) + EPS);
            float y[8];
#pragma unroll
            for (int e = 0; e < 8; ++e) y[e] = isv ? xv[e] : xv[e] * rstd * nwv[e];
            const int pr = pos >> 6, pc = pos & 63; const int pp = (li >> 3) ? pc : pr;
            const f32x4 cs0 = *(const f32x4*)(rt + pp * 32 + fi), cs1 = *(const f32x4*)(rt + pp * 32 + fi + 4), sn0 = *(const f32x4*)(rt + 2048 + pp * 32 + fi), sn1 = *(const f32x4*)(rt + 2048 + pp * 32 + fi + 4);
            const float csv[8] = {cs0.x, cs0.y, cs0.z, cs0.w, cs1.x, cs1.y, cs1.z, cs1.w}, snv[8] = {sn0.x, sn0.y, sn0.z, sn0.w, sn1.x, sn1.y, sn1.z, sn1.w};
            float o[8];
#pragma unroll
            for (int e = 0; e < 8; ++e) { const float xp = __shfl_xor(y[e], 4); const float r = y[e] * csv[e] + (first ? -xp : xp) * snv[e]; o[e] = (lat && !isv) ? r : y[e]; }
            const u32x4 w = pack8(o);
            if (isq) { *(u32x4*)(Q + (size_t)t * DM + hq * 128 + d0) = w; }
            else {
                const size_t krow = lat ? (size_t)(NCTX + sb * LKV + PAST + pos) : (size_t)t;
                *(u32x4*)((isv ? VB : KB) + krow * 256 + kvh * 128 + d0) = w;
                if (!lat) { float* dst = a.out + (isv ? O_CV : O_CK) + (((size_t)sb * DEPTH + l) * 256 + pos) * 256 + kvh * 128 + d0;
                    *(f32x4*)dst = (f32x4){o[0], o[1], o[2], o[3]}; *(f32x4*)(dst + 4) = (f32x4){o[4], o[5], o[6], o[7]}; }
            }
        }
        }
    }
}

namespace sd {
constexpr int RS = 272, RSX = 160;
constexpr int L_C = 0, L_B = 128 * RS, L_X = 2 * 128 * RS, L_H0 = L_X + 128 * RSX, L_H1 = L_H0 + 64 * RS, L_CUM = L_H1 + 64 * RS, L_DT = L_CUM + 512, L_WG = L_DT + 512, L_Y = L_WG + 512, RSY = 144, L_END = L_Y + 128 * RSY;
static_assert(L_END <= 144 * 1024 - 256, "ssd lds");
typedef short v4i16_t __attribute__((ext_vector_type(4)));
__device__ __forceinline__ f32x4 mfma16(bf16x8 a, bf16x8 b, f32x4 c) { return __builtin_amdgcn_mfma_f32_16x16x32_bf16(a, b, c, 0, 0, 0); }
__device__ __forceinline__ bf16x8 tr_frag(LAS unsigned char* p, int rs) {
    const v4i16_t lo = __builtin_amdgcn_ds_read_tr16_b64_v4i16((LAS v4i16_t*)p), hi = __builtin_amdgcn_ds_read_tr16_b64_v4i16((LAS v4i16_t*)(p + 4 * rs));
    return (bf16x8){lo[0], lo[1], lo[2], lo[3], hi[0], hi[1], hi[2], hi[3]};
}
__device__ __forceinline__ void ssd_item(const Ctx& c, int l, int item) {
    CArgs& a = *c.a; LAS unsigned char* lds = c.lds;
    const int tid = c.tid, lane = c.lane, w = c.wid, fr = lane & 15, fq = lane >> 4, tq = (lane & 15) >> 2, tp = lane & 3;
    int sb, dir, h, row_base, nc; bool lat;
    if (item < 128) { lat = true; sb = item >> 6; dir = (item >> 5) & 1; h = item & 31; row_base = NCTX + sb * 4096; nc = 32; }
    else { const int it = item - 128; lat = false; sb = it >> 6; dir = (it >> 5) & 1; h = it & 31; row_base = sb * 256; nc = 2; }
    const int g = h >> 3, dcol = dir * 32 + h; const float dskv = a.in[I_DSKIP][l * 32 + h];
    const bf16_t* XB = (const bf16_t*)(a.ws + WS_XBC); bf16_t* Y = (bf16_t*)(a.ws + (dir ? WS_YB : WS_YF));
    const float* dv = (const float*)(a.ws + WS_DTV); const float* cm = (const float*)(a.ws + WS_CUM);
    f32x4 hacc[4];
    if (lat) { const float* st = a.in[I_ST] + ((((size_t)sb * DEPTH + l) * 2 + dir) * 32 + h) * 8192;
#pragma unroll
        for (int pt = 0; pt < 4; ++pt)
#pragma unroll
            for (int j = 0; j < 4; ++j) hacc[pt][j] = st[(16 * pt + 4 * fq + j) * 128 + 16 * w + fr]; }
    else {
#pragma unroll
        for (int pt = 0; pt < 4; ++pt) hacc[pt] = (f32x4){0.f, 0.f, 0.f, 0.f}; }
#pragma unroll
    for (int pt = 0; pt < 4; ++pt)
#pragma unroll
        for (int j = 0; j < 4; ++j) *(LAS bf16_t*)(lds + L_H0 + (16 * pt + 4 * fq + j) * RS + (16 * w + fr) * 2) = (bf16_t)(cvtpk(hacc[pt][j], 0.f) & 0xffffu);
    LAS float* cumS = (LAS float*)(lds + L_CUM); LAS float* dtS = (LAS float*)(lds + L_DT); LAS float* wgS = (LAS float*)(lds + L_WG);
    const int ll = tid & 127;
    u32x4 pcv[4], pbv[4], pxv[2]; float pcmr, pdvr, pclast;
#define SSD_LOAD(cs_) do { const int ch_ = dir ? nc - 1 - (cs_) : (cs_); const int r0_ = row_base + ch_ * 128; \
        pclast = cm[(size_t)(r0_ + (dir ? 0 : 127)) * 64 + dcol]; \
        { const int row_ = r0_ + (dir ? 127 - ll : ll); pcmr = cm[(size_t)row_ * 64 + dcol]; pdvr = dv[(size_t)row_ * 64 + dcol]; } \
        _Pragma("unroll") for (int i = 0; i < 4; ++i) { const int q_ = tid + 512 * i, l_ = q_ >> 4, cx = q_ & 15; const bf16_t* xr_ = XB + (size_t)(r0_ + (dir ? 127 - l_ : l_)) * XBCW; \
            pcv[i] = *(const u32x4*)(xr_ + 2560 + g * 128 + cx * 8); pbv[i] = *(const u32x4*)(xr_ + 2048 + g * 128 + cx * 8); } \
        _Pragma("unroll") for (int i = 0; i < 2; ++i) { const int q_ = tid + 512 * i, l_ = q_ >> 3, cx = q_ & 7; const bf16_t* xr_ = XB + (size_t)(r0_ + (dir ? 127 - l_ : l_)) * XBCW; \
            pxv[i] = *(const u32x4*)(xr_ + h * 64 + cx * 8); } } while (0)
    SSD_LOAD(0);
    const int xoff = L_X + (8 * fq + tq) * RSX + 8 * tp, boff = L_B + (8 * fq + tq) * RS + (16 * w) * 2 + 8 * tp;
    for (int cs = 0; cs < nc; ++cs) {
        const int ch = dir ? nc - 1 - cs : cs; const int r0 = row_base + ch * 128;
        const int hcur = (cs & 1) ? L_H1 : L_H0, hnxt = (cs & 1) ? L_H0 : L_H1;
        const float cum_last = pclast;
        if (tid < 128) { cumS[ll] = pcmr; dtS[ll] = pdvr; wgS[ll] = __expf(cum_last - pcmr) * pdvr; }
#pragma unroll
        for (int i = 0; i < 4; ++i) { const int q_ = tid + 512 * i, l_ = q_ >> 4, cx = q_ & 15; *(LAS u32x4*)(lds + L_C + l_ * RS + cx * 16) = pcv[i]; *(LAS u32x4*)(lds + L_B + l_ * RS + cx * 16) = pbv[i]; }
#pragma unroll
        for (int i = 0; i < 2; ++i) { const int q_ = tid + 512 * i, l_ = q_ >> 3, cx = q_ & 7; *(LAS u32x4*)(lds + L_X + l_ * RSX + cx * 16) = pxv[i]; }
        if (cs + 1 < nc) SSD_LOAD(cs + 1);
        asm volatile("s_waitcnt lgkmcnt(0)" ::: "memory"); __builtin_amdgcn_s_barrier(); asm volatile("" ::: "memory");
        bf16x8 cfr[4];
#pragma unroll
        for (int ks = 0; ks < 4; ++ks) cfr[ks] = *(const LAS bf16x8*)(lds + L_C + (16 * w + fr) * RS + ks * 64 + fq * 16);
        float cl[4];
#pragma unroll
        for (int j = 0; j < 4; ++j) cl[j] = cumS[16 * w + 4 * fq + j];
        for (int ct = 0; ct <= w; ct += 2) {
            f32x4 cb0 = (f32x4){0.f, 0.f, 0.f, 0.f}, cb1 = (f32x4){0.f, 0.f, 0.f, 0.f};
#pragma unroll
            for (int ks = 0; ks < 4; ++ks) { cb0 = mfma16(cfr[ks], *(const LAS bf16x8*)(lds + L_B + (16 * ct + fr) * RS + ks * 64 + fq * 16), cb0);
                                             cb1 = mfma16(cfr[ks], *(const LAS bf16x8*)(lds + L_B + (16 * ct + 16 + fr) * RS + ks * 64 + fq * 16), cb1); }
            const int s0 = 16 * ct + fr, s1 = s0 + 16; const float csv0 = cumS[s0], dts0 = dtS[s0], csv1 = cumS[s1], dts1 = dtS[s1];
#pragma unroll
            for (int j = 0; j < 4; ++j) { const int lrow = 16 * w + 4 * fq + j;
                const float wv0 = (s0 <= lrow) ? cb0[j] * __expf(cl[j] - csv0) * dts0 : 0.f, wv1 = (s1 <= lrow) ? cb1[j] * __expf(cl[j] - csv1) * dts1 : 0.f;
                *(LAS bf16_t*)(lds + L_C + lrow * RS + s0 * 2) = (bf16_t)(cvtpk(wv0, 0.f) & 0xffffu); *(LAS bf16_t*)(lds + L_C + lrow * RS + s1 * 2) = (bf16_t)(cvtpk(wv1, 0.f) & 0xffffu); }
        }
        const int ksmax = (16 * w + 15) >> 5;
        float el[4];
#pragma unroll
        for (int j = 0; j < 4; ++j) el[j] = __expf(cl[j]);
#pragma unroll
        for (int pt = 0; pt < 4; ++pt) {
            f32x4 yo = (f32x4){0.f, 0.f, 0.f, 0.f}, yd = (f32x4){0.f, 0.f, 0.f, 0.f};
#pragma unroll
            for (int ks = 0; ks < 4; ++ks) yo = mfma16(cfr[ks], *(const LAS bf16x8*)(lds + hcur + (16 * pt + fr) * RS + ks * 64 + fq * 16), yo);
#pragma unroll
            for (int ks = 0; ks < 4; ++ks) if (ks <= ksmax) yd = mfma16(*(const LAS bf16x8*)(lds + L_C + (16 * w + fr) * RS + ks * 64 + fq * 16), tr_frag(lds + xoff + ks * 32 * RSX + pt * 32, RSX), yd);
#pragma unroll
            for (int j = 0; j < 4; ++j) { const int lr = 16 * w + 4 * fq + j;
                *(LAS bf16_t*)(lds + L_Y + lr * RSY + (16 * pt + fr) * 2) = (bf16_t)(cvtpk(yd[j] + el[j] * yo[j], 0.f) & 0xffffu); }
        }
#pragma unroll
        for (int i = 0; i < 2; ++i) { const int lr = 16 * w + 8 * i + (lane >> 3), cx = lane & 7; const int row = r0 + (dir ? 127 - lr : lr);
            u32x4 yv = *(const LAS u32x4*)(lds + L_Y + lr * RSY + cx * 16);
            if (dir == 0) { float yf[8], xf[8]; unpack8(yv, yf); unpack8(*(const LAS u32x4*)(lds + L_X + lr * RSX + cx * 16), xf);
#pragma unroll
                for (int e2 = 0; e2 < 8; ++e2) yf[e2] += dskv * xf[e2];
                yv = pack8(yf); }
            *(u32x4*)(Y + (size_t)row * DIN + h * 64 + cx * 8) = yv; }
        bf16x8 btf[4];
#pragma unroll
        for (int ks = 0; ks < 4; ++ks) {
            const bf16x8 raw = tr_frag(lds + boff + ks * 32 * RS, RS);
            const f32x4 w0 = *(const LAS f32x4*)(wgS + ks * 32 + 8 * fq), w1 = *(const LAS f32x4*)(wgS + ks * 32 + 8 * fq + 4);
            u32x4 rw = __builtin_bit_cast(u32x4, raw);
            u32x4 o; o.x = cvtpk(bflo(rw.x) * w0.x, bfhi(rw.x) * w0.y); o.y = cvtpk(bflo(rw.y) * w0.z, bfhi(rw.y) * w0.w); o.z = cvtpk(bflo(rw.z) * w1.x, bfhi(rw.z) * w1.y); o.w = cvtpk(bflo(rw.w) * w1.z, bfhi(rw.w) * w1.w);
            btf[ks] = __builtin_bit_cast(bf16x8, o);
        }
        const float ed = __expf(cum_last);
#pragma unroll
        for (int pt = 0; pt < 4; ++pt) {
            hacc[pt] = hacc[pt] * ed;
#pragma unroll
            for (int ks = 0; ks < 4; ++ks) hacc[pt] = mfma16(tr_frag(lds + xoff + ks * 32 * RSX + pt * 32, RSX), btf[ks], hacc[pt]);
#pragma unroll
            for (int j = 0; j < 4; ++j) *(LAS bf16_t*)(lds + hnxt + (16 * pt + 4 * fq + j) * RS + (16 * w + fr) * 2) = (bf16_t)(cvtpk(hacc[pt][j], 0.f) & 0xffffu);
        }
        asm volatile("s_waitcnt lgkmcnt(0)" ::: "memory"); __builtin_amdgcn_s_barrier(); asm volatile("" ::: "memory");
    }
#undef SSD_LOAD
    if (!lat) { float* st = a.out + O_ST + ((((size_t)sb * DEPTH + l) * 2 + dir) * 32 + h) * 8192;
#pragma unroll
        for (int pt = 0; pt < 4; ++pt)
#pragma unroll
            for (int j = 0; j < 4; ++j) st[(16 * pt + 4 * fq + j) * 128 + 16 * w + fr] = hacc[pt][j]; }
}
}

__device__ __forceinline__ void mixer_phase(const Ctx& c, int l, int r) {
    CArgs& a = *c.a; unsigned* ctr = (unsigned*)(a.ws + WS_CTL) + 64 * l + 16 * r;
    LAS int* slot = (LAS int*)(c.lds + LDS_BYTES - 64);
    const bf16_t* Q = (const bf16_t*)(a.ws + WS_Q); const bf16_t* KB = (const bf16_t*)(a.ws + WS_K); const bf16_t* VB = (const bf16_t*)(a.ws + WS_V); bf16_t* AO = (bf16_t*)(a.ws + WS_AO);
    constexpr int N_SL = 128, N_AL = 256, N_SC = 1024, N_AC = 128, N_ALL = N_SL + N_AL + N_SC + N_AC;
    for (;;) {
        __syncthreads();
        if (c.tid == 0) *slot = (int)atomicAdd(ctr, 1u);
        __syncthreads();
        const int it = __builtin_amdgcn_readfirstlane(*slot);
        if (it >= N_ALL) break;
        const bool is_ssd = it < N_SL || (it >= N_SL + N_AL && it < N_SL + N_AL + N_SC);
        Ctx c2 = c; { const int t_ = fresh_tid(c.wid); c2.tid = t_; c2.lane = t_ & 63; }
        if (is_ssd) { sd::ssd_item(c2, l, it < N_SL ? it : it - N_AL); }
        else {
            size_t qrow, krow; int hq, seq;
            if (it < N_SL + N_AL) { const int u = it - N_SL, b = u >> 7, rem = u & 127, kvh = rem >> 6, r2 = rem & 63, qb = r2 >> 2; hq = kvh * 4 + (r2 & 3);
                qrow = (size_t)NCTX + b * 4096 + qb * 256; krow = (size_t)NCTX + b * LKV; seq = LKV; }
            else { const int u = it - N_SL - N_AL - N_SC, b = u >> 3; hq = u & 7; qrow = (size_t)b * 256; krow = qrow; seq = 256; }
            const int kvh = hq >> 2;
            at::attn_body(Q + qrow * DM + hq * 128, KB + krow * 256 + kvh * 128, VB + krow * 256 + kvh * 128, AO + qrow * DM + hq * 128, seq, c.ldsg, c2.tid);
        }
    }
}

__device__ __forceinline__ void ssd_gate_phase(const Ctx& c, int l) {
    CArgs& a = *c.a; bf16_t* YF = (bf16_t*)(a.ws + WS_YF); const bf16_t* YB = (const bf16_t*)(a.ws + WS_YB); const bf16_t* XB = (const bf16_t*)(a.ws + WS_XBC); const bf16_t* P = (const bf16_t*)(a.ws + WS_P);
    const float* nw = a.in[I_SSDN] + (size_t)l * DIN;
    for (int t = c.gw; t < T; t += c.ngw) {
        float y[4][8]; float ss = 0.f;
#pragma unroll
        for (int j = 0; j < 4; ++j) { const int col = j * 512 + c.lane * 8;
            float f[8], b[8], z[8];
            unpack8(*(const u32x4*)(YF + (size_t)t * DIN + col), f); unpack8(*(const u32x4*)(YB + (size_t)t * DIN + col), b);
            unpack8(*(const u32x4*)(P + (size_t)t * PW + PC_Z + col), z);
#pragma unroll
            for (int e = 0; e < 8; ++e) { const float v = (f[e] + b[e]) * siluf_(z[e]); y[j][e] = v; ss += v * v; } }
        const float rstd = rsqrtf(wave_sum(ss) * (1.f / DIN) + EPS);
#pragma unroll
        for (int j = 0; j < 4; ++j) { const int col = j * 512 + c.lane * 8; const f32x4 w0 = *(const f32x4*)(nw + col), w1 = *(const f32x4*)(nw + col + 4);
            float o[8] = {y[j][0] * rstd * w0.x, y[j][1] * rstd * w0.y, y[j][2] * rstd * w0.z, y[j][3] * rstd * w0.w, y[j][4] * rstd * w1.x, y[j][5] * rstd * w1.y, y[j][6] * rstd * w1.z, y[j][7] * rstd * w1.w};
            *(u32x4*)(YF + (size_t)t * DIN + col) = pack8(o); }
    }
}

__device__ __forceinline__ void ffn_act_phase(const Ctx& c, int l) {
    CArgs& a = *c.a; const bf16_t* U = (const bf16_t*)(a.ws + WS_P); bf16_t* ACT = (bf16_t*)(a.ws + WS_XBC);
    const float* fw = a.in[I_FCW] + (size_t)l * 3 * UPW; const float* fb = a.in[I_FCB] + (size_t)l * UPW;
    constexpr int NRUN = T / 32;
    for (int id = c.gw; id < NRUN * 6; id += c.ngw) {
        const int run = id / 6, wt = id % 6, t0 = run * 32; const int ci = wt * 64 + c.lane; if (ci >= DFF / 8) continue; const int c0 = ci * 8;
        const bool lat = t0 >= NCTX; const int tt = lat ? t0 - NCTX : t0; const int pos0 = lat ? tt & 4095 : tt & 255, L = lat ? 4096 : 256;
        float wv0[8], wv1[8], wv2[8], wg0[8], wg1[8], wg2[8], bv[8], bg[8];
#pragma unroll
        for (int e = 0; e < 8; ++e) { wv0[e] = fw[c0 + e]; wv1[e] = fw[UPW + c0 + e]; wv2[e] = fw[2 * UPW + c0 + e]; wg0[e] = fw[DFF + c0 + e]; wg1[e] = fw[UPW + DFF + c0 + e]; wg2[e] = fw[2 * UPW + DFF + c0 + e];
            bv[e] = fb[c0 + e]; bg[e] = fb[DFF + c0 + e]; }
        const bf16_t* base = U + (size_t)t0 * UPW + c0; bf16_t* ob = ACT + (size_t)t0 * DFF + c0;
        const u32x4 zz = zero4();
        const bool tail_ok = pos0 + 32 < L;
        u32x4 V[10], G[10], NV[8], NG[8];
        V[0] = zz; G[0] = zz; if (pos0 > 0) { V[0] = *(const u32x4*)(base - UPW); G[0] = *(const u32x4*)(base - UPW + DFF); }
        V[1] = *(const u32x4*)base; G[1] = *(const u32x4*)(base + DFF);
#pragma unroll
        for (int j = 0; j < 8; ++j) { V[2 + j] = *(const u32x4*)(base + (size_t)(1 + j) * UPW); G[2 + j] = *(const u32x4*)(base + (size_t)(1 + j) * UPW + DFF); }
        for (int blk = 0; blk < 4; ++blk) {
            const int i0 = blk * 8;
            if (blk < 3) {
#pragma unroll
                for (int j = 0; j < 8; ++j) { const int idx = i0 + 9 + j;
                    if (idx < 32 || tail_ok) { NV[j] = *(const u32x4*)(base + (size_t)idx * UPW); NG[j] = *(const u32x4*)(base + (size_t)idx * UPW + DFF); } else { NV[j] = zz; NG[j] = zz; } }
            }
#pragma unroll
            for (int j = 0; j < 8; ++j) {
                float xa[8], xb[8], xc[8], ya[8], yb[8], yc[8], o[8];
                unpack8(V[j], xa); unpack8(V[j + 1], xb); unpack8(V[j + 2], xc); unpack8(G[j], ya); unpack8(G[j + 1], yb); unpack8(G[j + 2], yc);
#pragma unroll
                for (int e = 0; e < 8; ++e) { const float uv = bv[e] + wv0[e] * xa[e] + wv1[e] * xb[e] + wv2[e] * xc[e]; const float ug = bg[e] + wg0[e] * ya[e] + wg1[e] * yb[e] + wg2[e] * yc[e]; o[e] = siluf_(ug) * uv; }
                *(u32x4*)(ob + (size_t)(i0 + j) * DFF) = pack8(o);
            }
            V[0] = V[8]; V[1] = V[9]; G[0] = G[8]; G[1] = G[9];
#pragma unroll
            for (int j = 0; j < 8; ++j) { V[2 + j] = NV[j]; G[2 + j] = NG[j]; }
        }
    }
}

namespace pg8 {
using gm::BM; using gm::BK; using gm::HALF; using gm::HTB; using gm::NXCD; using gm::WGM; using gm::lds_byte; using gm::stage_rc;
#define PG8_LAS LAS
__host__ __device__ __forceinline__ int perm32(int rho) { const int n = rho >> 4, i = rho & 15; return 8 * (i >> 2) + 4 * n + (i & 3); }
struct Unit { int pm, pn; };
struct Gemm { const bf16_t* A; const bf16_t* Bt; int M, N, K; };

struct StaticOrder {
    int nM, nN, nwg, G, c;
    __host__ __device__ void init(int M, int N, int G_, int c_, int bm = BM) { nM = M / bm; nN = N / BM; nwg = nM * nN; G = G_; c = c_; }
    __host__ __device__ bool next(int i, Unit& u) const {
        const long L = (long)i * G + c; if (L >= nwg) return false;
        int wgid = (int)L; { const int q = nwg / NXCD, r = nwg % NXCD, xcd = wgid % NXCD, off = wgid / NXCD; wgid = (xcd < r ? xcd * (q + 1) : r * (q + 1) + (xcd - r) * q) + off; }
        const int nig = WGM * nN, gid = wgid / nig, fm = gid * WGM, gsz = (nM - fm) < WGM ? (nM - fm) : WGM;
        u.pm = fm + ((wgid % nig) % gsz); u.pn = (wgid % nig) / gsz; return true;
    }
    __device__ __forceinline__ void a_ready(const Unit&) const {}
    __device__ __forceinline__ void done(const Unit&) const {}
};
template <class Epi, class Sched, bool ALIGN_EPI = false, bool SP2 = false, int MT = 4>
__device__ __forceinline__ void gemm_phase(PG8_LAS unsigned char* lds, const int tid, const Gemm g, const Sched& S, const Epi& E) {
    const int wid = __builtin_amdgcn_readfirstlane(tid >> 6), lane = tid & 63, wr = wid >> 2, wc = wid & 3, fr = lane & 15, fq = lane >> 4;
    const int K = g.K, nt = K / BK;
    unsigned voffA[2], voffB[2];
#pragma unroll
    for (int i = 0; i < 2; ++i) { int R, C; stage_rc(tid * 16 + i * 8192, R, C); const int Rb = Epi::PERM ? ((R & ~31) + perm32(R & 31)) : R;
        voffA[i] = (unsigned)(R * K + C) * 2u; voffB[i] = (unsigned)(Rb * K + C) * 2u; }
    const size_t kstep = (size_t)(BK * 2);
    const size_t hstepA = (size_t)(MT * 32) * K * 2, hstepB = (size_t)HALF * K * 2;
    const size_t tstepA = 2 * hstepA, tstepB = 2 * hstepB;
    const unsigned ldsw = (unsigned)wid * 1024u;
    const int aoff = lds_byte(wr * (MT * 16) + fr, fq * 8), boff = lds_byte(wc * 32 + fr, fq * 8);
#define PG8_SA(b, h) (((b) * 2 + (h)) * HTB)
#define PG8_SB(b, h) ((4 + (b) * 2 + (h)) * HTB)
#define PG8_STAGE(bufoff, gbase, voff) do { _Pragma("unroll") for (int _i = 0; _i < 2; ++_i) \
        __builtin_amdgcn_global_load_lds((const unsigned*)((const char*)(gbase) + (voff)[_i]), (PG8_LAS unsigned*)(lds + (bufoff) + ldsw + _i * 8192), 16, 0, 0); } while (0)
#define PG8_LDA(dst, b, h) do { _Pragma("unroll") for (int m = 0; m < MT; ++m) _Pragma("unroll") for (int k = 0; k < 2; ++k) dst[m][k] = *(const PG8_LAS bf16x8*)(lds + PG8_SA(b, h) + aoff + m * 2048 + k * 1024); } while (0)
#define PG8_LDB(dst, b, h) do { _Pragma("unroll") for (int n = 0; n < 2; ++n) _Pragma("unroll") for (int k = 0; k < 2; ++k) dst[n][k] = *(const PG8_LAS bf16x8*)(lds + PG8_SB(b, h) + boff + n * 2048 + k * 1024); } while (0)
#define PG8_MMA(ai, bj, At, Bt) do { __builtin_amdgcn_s_setprio(1); _Pragma("unroll") for (int m = 0; m < MT; ++m) _Pragma("unroll") for (int n = 0; n < 2; ++n) _Pragma("unroll") for (int k = 0; k < 2; ++k) \
        acc[ai][bj][m][n] = __builtin_amdgcn_mfma_f32_16x16x32_bf16(Bt[n][k], At[m][k], acc[ai][bj][m][n], 0, 0, 0); __builtin_amdgcn_s_setprio(0); } while (0)
#define PG8_WAIT_V(n) asm volatile("s_waitcnt vmcnt(" #n ")" ::: "memory")
#define PG8_WAIT_L(n) asm volatile("s_waitcnt lgkmcnt(" #n ")" ::: "memory")
#define PG8_BAR __builtin_amdgcn_s_barrier()
#define PG8_SCHED __builtin_amdgcn_sched_barrier(0)
    Unit cur, nxt; int ui = 0;
    if (!S.next(0, cur)) return;
    f32x4 acc[2][2][4][2];
#pragma unroll
    for (int a = 0; a < 2; ++a)
#pragma unroll
        for (int b = 0; b < 2; ++b)
#pragma unroll
            for (int m = 0; m < 4; ++m)
#pragma unroll
                for (int n = 0; n < 2; ++n) acc[a][b][m][n] = (f32x4){0.f, 0.f, 0.f, 0.f};
    bf16x8 At[4][2], B0[2][2], B1[2][2];
    const char* cA = (const char*)g.A + (size_t)cur.pm * tstepA; const char* cB = (const char*)g.Bt + (size_t)cur.pn * tstepB;
    S.a_ready(cur);
    if constexpr (SP2) {
        PG8_STAGE(PG8_SB(0, 0), cB, voffB); PG8_STAGE(PG8_SB(0, 1), cB + hstepB, voffB); PG8_STAGE(PG8_SA(0, 0), cA, voffA); PG8_STAGE(PG8_SA(0, 1), cA + hstepA, voffA);
        if (wr == 1) PG8_BAR;
        PG8_WAIT_V(2); PG8_BAR;
        PG8_STAGE(PG8_SB(1, 0), cB + kstep, voffB); PG8_STAGE(PG8_SA(1, 0), cA + kstep, voffA); PG8_STAGE(PG8_SB(1, 1), cB + hstepB + kstep, voffB);
        PG8_WAIT_V(6); PG8_BAR;
    } else {
        PG8_STAGE(PG8_SB(0, 0), cB, voffB); PG8_STAGE(PG8_SA(0, 0), cA, voffA); PG8_STAGE(PG8_SB(0, 1), cB + hstepB, voffB); PG8_STAGE(PG8_SA(0, 1), cA + hstepA, voffA);
        if (wr == 1) PG8_BAR;
        PG8_WAIT_V(4); PG8_BAR;
        PG8_STAGE(PG8_SB(1, 0), cB + kstep, voffB); PG8_STAGE(PG8_SA(1, 0), cA + kstep, voffA); PG8_STAGE(PG8_SB(1, 1), cB + hstepB + kstep, voffB);
        PG8_WAIT_V(6); PG8_BAR;
    }
    for (;;) {
        const bool has_next = S.next(ui + 1, nxt);
        const char* nA = has_next ? (const char*)g.A + (size_t)nxt.pm * tstepA : cA; const char* nB = has_next ? (const char*)g.Bt + (size_t)nxt.pn * tstepB : cB;
        for (int t = 0; t < nt; t += 2) {
            const bool last = (t == nt - 2);
            const char* a1 = cA + (size_t)(t + 1) * kstep;
            const char* a2 = last ? nA : cA + (size_t)(t + 2) * kstep; const char* b2 = last ? nB : cB + (size_t)(t + 2) * kstep;
            const char* a3 = a2 + kstep; const char* b3 = b2 + kstep;
            if (last && has_next) S.a_ready(nxt);
            if constexpr (SP2) {
            PG8_LDB(B0, 0, 0); PG8_LDB(B1, 0, 1); PG8_SCHED; PG8_LDA(At, 0, 0); PG8_STAGE(PG8_SA(1, 1), a1 + hstepA, voffA);
            PG8_WAIT_V(8); PG8_WAIT_L(0); PG8_BAR; PG8_MMA(0, 0, At, B0); PG8_MMA(0, 1, At, B1); PG8_BAR; PG8_SCHED;
            PG8_LDA(At, 0, 1); PG8_STAGE(PG8_SB(0, 0), b2, voffB); PG8_STAGE(PG8_SB(0, 1), b2 + hstepB, voffB); PG8_STAGE(PG8_SA(0, 0), a2, voffA);
            PG8_WAIT_V(8); PG8_WAIT_L(0); PG8_BAR; PG8_MMA(1, 0, At, B0); PG8_MMA(1, 1, At, B1); PG8_BAR; PG8_SCHED;
            PG8_LDB(B0, 1, 0); PG8_LDB(B1, 1, 1); PG8_SCHED; PG8_LDA(At, 1, 0); PG8_STAGE(PG8_SA(0, 1), a2 + hstepA, voffA);
            PG8_WAIT_V(8); PG8_WAIT_L(0); PG8_BAR; PG8_MMA(0, 0, At, B0); PG8_MMA(0, 1, At, B1); PG8_BAR; PG8_SCHED;
            PG8_LDA(At, 1, 1); PG8_STAGE(PG8_SB(1, 0), b3, voffB); PG8_STAGE(PG8_SB(1, 1), b3 + hstepB, voffB); PG8_STAGE(PG8_SA(1, 0), a3, voffA);
            PG8_WAIT_V(8); PG8_WAIT_L(0); PG8_BAR; PG8_MMA(1, 0, At, B0); PG8_MMA(1, 1, At, B1); PG8_BAR; PG8_SCHED;
            } else {
            PG8_LDB(B0, 0, 0); PG8_SCHED; PG8_LDA(At, 0, 0); PG8_STAGE(PG8_SA(1, 1), a1 + hstepA, voffA);
            PG8_WAIT_L(8); PG8_BAR; PG8_WAIT_L(0); PG8_MMA(0, 0, At, B0); PG8_BAR; PG8_SCHED;
            PG8_LDB(B1, 0, 1); PG8_STAGE(PG8_SB(0, 0), b2, voffB);
            PG8_BAR; PG8_WAIT_L(0); PG8_MMA(0, 1, At, B1); PG8_BAR;
            PG8_LDA(At, 0, 1); PG8_STAGE(PG8_SA(0, 0), a2, voffA);
            PG8_BAR; PG8_WAIT_L(0); PG8_MMA(1, 0, At, B0); PG8_BAR; PG8_SCHED;
            PG8_STAGE(PG8_SB(0, 1), b2 + hstepB, voffB);
            PG8_WAIT_V(6); PG8_BAR; PG8_MMA(1, 1, At, B1); PG8_BAR;
            PG8_LDB(B0, 1, 0); PG8_SCHED; PG8_LDA(At, 1, 0); PG8_STAGE(PG8_SA(0, 1), a2 + hstepA, voffA);
            PG8_WAIT_L(8); PG8_BAR; PG8_WAIT_L(0); PG8_MMA(0, 0, At, B0); PG8_BAR; PG8_SCHED;
            PG8_LDB(B1, 1, 1); PG8_STAGE(PG8_SB(1, 0), b3, voffB);
            PG8_BAR; PG8_WAIT_L(0); PG8_MMA(0, 1, At, B1); PG8_BAR;
            PG8_LDA(At, 1, 1); PG8_STAGE(PG8_SA(1, 0), a3, voffA);
            PG8_BAR; PG8_WAIT_L(0); PG8_MMA(1, 0, At, B0); PG8_BAR; PG8_SCHED;
            PG8_STAGE(PG8_SB(1, 1), b3 + hstepB, voffB);
            PG8_WAIT_V(6); PG8_BAR; PG8_MMA(1, 1, At, B1); PG8_BAR;
            }
        }
        if constexpr (ALIGN_EPI) { if (wr == 0) PG8_BAR; }
        if constexpr (!Epi::AFTER_DRAIN) { E(acc, cur, wr, wc, fr, fq); S.done(cur); }
        if (!has_next) break;
#pragma unroll
        for (int a = 0; a < 2; ++a)
#pragma unroll
            for (int b = 0; b < 2; ++b)
#pragma unroll
                for (int m = 0; m < 4; ++m)
#pragma unroll
                    for (int n = 0; n < 2; ++n) acc[a][b][m][n] = (f32x4){0.f, 0.f, 0.f, 0.f};
        cur = nxt; cA = nA; cB = nB; ++ui;
        if constexpr (ALIGN_EPI) { if (wr == 1) PG8_BAR; }
    }
    PG8_WAIT_V(0);
    if constexpr (!ALIGN_EPI) { if (wr == 0) PG8_BAR; }
    PG8_BAR;
    if constexpr (Epi::AFTER_DRAIN) { E.fused(acc, cur, wr, wc, fr, fq, lds, wid, lane); S.done(cur); }
#undef PG8_SA
#undef PG8_SB
#undef PG8_STAGE
#undef PG8_LDA
#undef PG8_LDB
#undef PG8_MMA
#undef PG8_WAIT_V
#undef PG8_WAIT_L
#undef PG8_BAR
#undef PG8_SCHED
}
}

struct EpiStoreBf16 {
    static constexpr bool PERM = true, AFTER_DRAIN = false;
    bf16_t* O; int ldc; float* DR; int dt_pn;
    __device__ __forceinline__ void operator()(const f32x4 (&acc)[2][2][4][2], const pg8::Unit& u, int wr, int wc, int fr, int fq) const {
        const int row0 = u.pm * 256 + wr * 64 + fr;
        if (u.pn != dt_pn) {
            const int col0 = u.pn * 256 + wc * 32 + 8 * fq;
#pragma unroll
            for (int ai = 0; ai < 2; ++ai)
#pragma unroll
                for (int m = 0; m < 4; ++m) { bf16_t* rowp = O + (size_t)(row0 + ai * 128 + m * 16) * ldc + col0;
#pragma unroll
                    for (int bj = 0; bj < 2; ++bj) { const f32x4 v0 = acc[ai][bj][m][0], v1 = acc[ai][bj][m][1];
                        u32x4 w; w.x = cvtpk(v0[0], v0[1]); w.y = cvtpk(v0[2], v0[3]); w.z = cvtpk(v1[0], v1[1]); w.w = cvtpk(v1[2], v1[3]);
                        *(u32x4*)(rowp + bj * 128) = w; } }
        } else if (wc < 2) {
#pragma unroll
            for (int ai = 0; ai < 2; ++ai)
#pragma unroll
                for (int m = 0; m < 4; ++m) { float* rp = DR + (size_t)(row0 + ai * 128 + m * 16) * 64 + wc * 32 + 8 * fq;
                    *(f32x4*)rp = acc[ai][0][m][0]; *(f32x4*)(rp + 4) = acc[ai][0][m][1]; }
        }
    }
};
template <bool SECOND, int MT> struct EpiGate {
    static constexpr bool PERM = true, AFTER_DRAIN = false;
    bf16_t* MG; const bf16_t* G;
    __device__ __forceinline__ void operator()(const f32x4 (&acc)[2][2][4][2], const pg8::Unit& u, int wr, int wc, int fr, int fq) const {
        const int row0 = u.pm * (64 * MT) + wr * (16 * MT) + fr, col0 = u.pn * 256 + wc * 32 + 8 * fq;
#pragma unroll
        for (int ai = 0; ai < 2; ++ai)
#pragma unroll
            for (int m = 0; m < MT; ++m) { const size_t row = (size_t)(row0 + ai * (32 * MT) + m * 16);
#pragma unroll
                for (int bj = 0; bj < 2; ++bj) { const int col = col0 + bj * 128;
                    float gv[8]; unpack8(*(const u32x4*)(G + row * PW + col), gv);
                    float t1[8] = {0.f, 0.f, 0.f, 0.f, 0.f, 0.f, 0.f, 0.f};
                    if (SECOND) unpack8(*(const u32x4*)(MG + row * DM + col), t1);
                    const f32x4 v0 = acc[ai][bj][m][0], v1 = acc[ai][bj][m][1];
                    float o[8];
#pragma unroll
                    for (int e = 0; e < 4; ++e) { o[e] = t1[e] + v0[e] * sigmoidf_(gv[e]); o[4 + e] = t1[4 + e] + v1[e] * sigmoidf_(gv[4 + e]); }
                    *(u32x4*)(MG + row * DM + col) = pack8(o); }
                asm volatile("" ::: "memory"); }
    }
};
template <int MT> struct EpiRes {
    static constexpr bool PERM = false, AFTER_DRAIN = false;
    float* X; const float* modl; bool fin;
    __device__ __forceinline__ void operator()(const f32x4 (&acc)[2][2][4][2], const pg8::Unit& u, int wr, int wc, int fr, int fq) const {
        const int row0 = u.pm * (64 * MT) + wr * (16 * MT) + fr, col0 = u.pn * 256 + wc * 32 + 4 * fq;
#pragma unroll
        for (int ai = 0; ai < 2; ++ai)
#pragma unroll
            for (int m = 0; m < MT; ++m) { const int row = row0 + ai * (32 * MT) + m * 16; float* xp = X + (size_t)row * DM + col0;
                const float* gp = modl + mod_idx(u.pm * (64 * MT) + wr * (16 * MT) + ai * (32 * MT) + m * 16) * 6144 + col0;
#pragma unroll
                for (int bj = 0; bj < 2; ++bj)
#pragma unroll
                    for (int n = 0; n < 2; ++n) { float* p = xp + bj * 128 + n * 16; const f32x4 gv = *(const f32x4*)(gp + bj * 128 + n * 16); if (fin) *(f32x4*)p = *(const f32x4*)p + gv * acc[ai][bj][m][n]; }
                asm volatile("" ::: "memory"); }
    }
};

__device__ __forceinline__ void g1_phase(const Ctx& c, int l) {
    CArgs& a = *c.a;
    pg8::Gemm g{(const bf16_t*)(a.ws + WS_H), (const bf16_t*)(a.ws + WS_W + (size_t)(l & 1) * WS_WSTRIDE) + W_IN, T, INWP, DM};
    pg8::StaticOrder S; S.init(T, INWP, (int)gridDim.x, (int)blockIdx.x);
    EpiStoreBf16 E{(bf16_t*)(a.ws + WS_P), PW, (float*)(a.ws + WS_DTR), INWP / 256 - 1};
    pg8::gemm_phase<EpiStoreBf16, pg8::StaticOrder, true, true>(c.lds, c.tid, g, S, E);
}
__device__ __forceinline__ void g2_phase(const Ctx& c, int l) {
    CArgs& a = *c.a; const bf16_t* W = (const bf16_t*)(a.ws + WS_W + (size_t)(l & 1) * WS_WSTRIDE); const bf16_t* P = (const bf16_t*)(a.ws + WS_P); bf16_t* MG = (bf16_t*)(a.ws + WS_H);
    if (blockIdx.x >= 192) {
        if (l + 1 < DEPTH) convert_weights(c, l + 1, (int)(blockIdx.x - 192) * 8 + c.wid, (int)(gridDim.x - 192) * 8);
        return;
    }
    pg8::StaticOrder S; S.init(T, 1024, (int)gridDim.x, (int)blockIdx.x);
    { pg8::Gemm g{(const bf16_t*)(a.ws + WS_AO), W + W_AO, T, 1024, 1024}; EpiGate<false, 4> E{MG, P + PC_GA};
      pg8::gemm_phase<EpiGate<false, 4>, pg8::StaticOrder, true, true, 4>(c.lds, c.tid, g, S, E); }
    const int t2 = fresh_tid(c.wid);
    { pg8::Gemm g{(const bf16_t*)(a.ws + WS_YF), W + W_SO, T, 1024, 2048}; EpiGate<true, 4> E{MG, P + PC_GS};
      pg8::gemm_phase<EpiGate<true, 4>, pg8::StaticOrder, true, true, 4>(c.lds, t2, g, S, E); }
}
__device__ __forceinline__ void gres_phase(const Ctx& c, int l, const bf16_t* A, int K, const bf16_t* W, int gate_off, bool fin) {
    CArgs& a = *c.a;
    pg8::Gemm g{A, W, T, 1024, K}; pg8::StaticOrder S; S.init(T, 1024, (int)gridDim.x, (int)blockIdx.x, 192);
    EpiRes<3> E{a.out + O_X, (const float*)(a.ws + WS_MOD) + (size_t)l * 3 * 6144 + gate_off, fin};
    pg8::gemm_phase<EpiRes<3>, pg8::StaticOrder, true, true, 3>(c.lds, c.tid, g, S, E);
}
__device__ __forceinline__ void g4_phase(const Ctx& c, int l) {
    CArgs& a = *c.a;
    pg8::Gemm g{(const bf16_t*)(a.ws + WS_H), (const bf16_t*)(a.ws + WS_W + (size_t)(l & 1) * WS_WSTRIDE) + W_UP, T, UPW, DM};
    pg8::StaticOrder S; S.init(T, UPW, (int)gridDim.x, (int)blockIdx.x);
    EpiStoreBf16 E{(bf16_t*)(a.ws + WS_P), UPW, nullptr, -1};
    pg8::gemm_phase<EpiStoreBf16, pg8::StaticOrder, true, true>(c.lds, c.tid, g, S, E);
}

#define XB_TMO      128
#define XB_XCNT(j)  (256  + 64 * (j))
#define XB_XSUB(j)  (1280 + 64 * (j))
#define XB_XGEN(j)  (2304 + 64 * (j))
#define XB_TOP      3328
#define XB_TOPGEN   3392
#define XCD_BAR_WORDS 3456
#define XB_SPIN_CAP (1u << 18)
__device__ __forceinline__ unsigned xb_ld(unsigned* p)              { return __hip_atomic_load(p, __ATOMIC_RELAXED, __HIP_MEMORY_SCOPE_AGENT); }
__device__ __forceinline__ unsigned xb_add(unsigned* p, unsigned v) { return __hip_atomic_fetch_add(p, v, __ATOMIC_RELAXED, __HIP_MEMORY_SCOPE_AGENT); }
__device__ __forceinline__ unsigned xb_xcc_id() { return (unsigned)__builtin_amdgcn_s_getreg((3 << 11) | 20) & 0xFu; }
#define XB_SPIN(cond, bar) do { unsigned _sp = 0; while (cond) { __builtin_amdgcn_s_sleep(1); \
    if ((++_sp & 255u) == 0u) { if (xb_ld(&(bar)[XB_TMO])) break; if (_sp > XB_SPIN_CAP) { atomicAdd(&(bar)[XB_TMO], 1u); break; } } } } while (0)
struct XcdBarrier { unsigned* bar; unsigned x; volatile LAS unsigned* st; };
__device__ __forceinline__ XcdBarrier xcd_barrier_post(unsigned* bar, volatile LAS unsigned* st) {
    XcdBarrier b; b.bar = bar; b.x = xb_xcc_id(); b.st = st;
    if (threadIdx.x == 0) (void)xb_add(&bar[XB_XCNT(b.x)], 1u);
    return b;
}
__device__ __forceinline__ void xcd_barrier_complete(unsigned* bar, unsigned x, unsigned& nloc, unsigned& nx) {
    const unsigned G = gridDim.x * gridDim.y * gridDim.z;
    unsigned sum, cnt, mine, sp = 0u;
    for (;;) {
        sum = 0u; cnt = 0u; mine = 0u;
#pragma unroll
        for (unsigned j = 0; j < 16; ++j) { const unsigned c = xb_ld(&bar[XB_XCNT(j)]); sum += c; cnt += (c > 0u) ? 1u : 0u; mine = (j == x) ? c : mine; }
        if (sum == G) break;
        __builtin_amdgcn_s_sleep(1);
        if ((++sp & 255u) == 0u) { if (xb_ld(&bar[XB_TMO])) break; if (sp > XB_SPIN_CAP) { atomicAdd(&bar[XB_TMO], 1u); break; } }
    }
    nloc = mine > 0u ? mine : 1u; nx = cnt > 0u ? cnt : 1u;
}
__device__ __forceinline__ void xcd_barrier(const XcdBarrier& b) {
    asm volatile("s_waitcnt vmcnt(0)" ::: "memory");
    __syncthreads();
    if (threadIdx.x == 0) {
        unsigned* bar = b.bar;
        __builtin_amdgcn_s_waitcnt(0);
        unsigned nloc = b.st[0], nx = b.st[1];
        if (nloc == 0u) { xcd_barrier_complete(bar, b.x, nloc, nx); b.st[0] = nloc; b.st[1] = nx; }
        const unsigned old = xb_add(&bar[XB_XSUB(b.x)], 1u);
        const unsigned gen = old / nloc;
        if (old + 1u == (gen + 1u) * nloc) {
            __builtin_amdgcn_fence(__ATOMIC_RELEASE, "agent");
            asm volatile("s_waitcnt vmcnt(0)" ::: "memory");
            const unsigned og = xb_add(&bar[XB_TOP], 1u);
            const unsigned tg = og / nx;
            if (og + 1u == (tg + 1u) * nx) xb_add(&bar[XB_TOPGEN], 1u);
            else XB_SPIN(xb_ld(&bar[XB_TOPGEN]) == tg, bar);
            __builtin_amdgcn_fence(__ATOMIC_ACQUIRE, "agent");
            xb_add(&bar[XB_XGEN(b.x)], 1u);
            asm volatile("s_waitcnt vmcnt(0)" ::: "memory");
        } else {
            XB_SPIN(xb_ld(&bar[XB_XGEN(b.x)]) == gen, bar);
            __builtin_amdgcn_fence(__ATOMIC_ACQUIRE, "agent");
            asm volatile("s_waitcnt vmcnt(0)" ::: "memory");
        }
    }
    __syncthreads();
}

__global__ void __launch_bounds__(512) mega(Args args) {
    extern __shared__ __attribute__((aligned(16))) unsigned char smem[];
    const int ph_lo = args.ph_lo, ph_hi = args.ph_hi, coop = args.coop;
    const int wid0 = __builtin_amdgcn_readfirstlane(threadIdx.x >> 6);
    volatile LAS unsigned* bst = (volatile LAS unsigned*)((LAS unsigned char*)smem + LDS_BYTES - 32);
    if (threadIdx.x < 2) bst[threadIdx.x] = 0u;
    __syncthreads();
    const XcdBarrier xbar = xcd_barrier_post((unsigned*)(args.ws + WS_CTL) + 4096, bst);
    if (ph_lo == 0) {
        Ctx c; c.a = (ArgsP)__builtin_amdgcn_kernarg_segment_ptr(); c.lds = (LAS unsigned char*)smem; c.ldsg = (char*)smem; c.tid = threadIdx.x; c.lane = c.tid & 63; c.wid = __builtin_amdgcn_readfirstlane(c.tid >> 6);
        c.gw = blockIdx.x * 8 + c.wid; c.ngw = gridDim.x * 8;
        setup_phase(c);
        if (1 < ph_hi) { if (coop == 2) cg::this_grid().sync(); else if (coop) xcd_barrier(xbar); }
        __syncthreads();
    }
    for (int ph = (ph_lo < 1 ? 1 : ph_lo); ph < ph_hi; ++ph) {
        const int l = (ph - 1) / NPH_LAYER, sp = (ph - 1) % NPH_LAYER;
        const int nrep = (REP_MASK != 0 && ((REP_MASK >> sp) & 1)) ? 2 : 1;
        for (int r = 0; r < nrep; ++r) {
            const bool fin = (r == nrep - 1);
            Ctx c; { ArgsP ap = (ArgsP)__builtin_amdgcn_kernarg_segment_ptr(); asm volatile("" : "+s"(ap)); c.a = ap; }
            c.lds = (LAS unsigned char*)smem; c.ldsg = (char*)smem;
            c.tid = fresh_tid(wid0);
            c.lane = c.tid & 63; c.wid = wid0;
            c.gw = blockIdx.x * 8 + c.wid; c.ngw = gridDim.x * 8;
            const bf16_t* Wl = (const bf16_t*)(c.a->ws + WS_W + (size_t)(l & 1) * WS_WSTRIDE);
            switch (sp) {
                case 0: if (l > 0 && gridDim.x <= 192) convert_weights(c, l, c.gw, c.ngw);
                        modulate_phase(c, l, 0); break;
                case 1: g1_phase(c, l); break;
                case 2: e2_phase(c, l); break;
                case 3: mixer_phase(c, l, r); break;
                case 4: ssd_gate_phase(c, l); break;
                case 5: g2_phase(c, l); break;
                case 6: gres_phase(c, l, (const bf16_t*)(c.a->ws + WS_H), 1024, Wl + W_OUT, 2048, fin); break;
                case 7: modulate_phase(c, l, 1); break;
                case 8: g4_phase(c, l); break;
                case 9: ffn_act_phase(c, l); break;
                default: gres_phase(c, l, (const bf16_t*)(c.a->ws + WS_XBC), DFF, Wl + W_DN, 5120, fin); break;
            }
            if (!fin) { if (coop) xcd_barrier(xbar); __syncthreads(); }
        }
#ifdef EXTRA_SYNC
        for (int es = 0; es < EXTRA_SYNC; ++es) { if (coop) xcd_barrier(xbar); }
#endif
        if (ph + 1 < ph_hi) { if (coop) xcd_barrier(xbar); }
        __syncthreads();
    }
}

extern "C" void kernel_launch(void* const* d_in, const int* in_sizes, int n_in, void* d_out, int out_size, void* d_ws, size_t ws_size, hipStream_t stream) {
    static int grid = 0;
    if (grid == 0) {
        if (n_in != 25 || ws_size < WS_END) { fprintf(stderr, "kernel_launch: unexpected n_in %d or ws_size %zu (< %zu)\n", n_in, ws_size, (size_t)WS_END); grid = -1; return; }
        if (hipFuncSetAttribute((const void*)mega, hipFuncAttributeMaxDynamicSharedMemorySize, LDS_BYTES) != hipSuccess) { fprintf(stderr, "kernel_launch: hipFuncSetAttribute failed\n"); grid = -1; return; }
        int dev = 0, cus = 0, per_cu = 0;
        hipGetDevice(&dev); hipDeviceGetAttribute(&cus, hipDeviceAttributeMultiprocessorCount, dev);
        hipOccupancyMaxActiveBlocksPerMultiprocessor(&per_cu, (const void*)mega, 512, LDS_BYTES);
        if (per_cu < 1) { fprintf(stderr, "kernel_launch: occupancy query says %d blocks/CU\n", per_cu); per_cu = 1; }
        (void)hipGetLastError();
        grid = cus * 1;
    }
    if (grid < 0) return;
    hipMemsetAsync((char*)d_ws + WS_CTL, 0, WS_ROPE, stream);
    Args a{};
    for (int i = 0; i < 25; ++i) a.in[i] = (const float*)d_in[i];
    a.out = (float*)d_out; a.ws = (unsigned char*)d_ws; a.pad = 0;
#if MK_MULTI
    for (int ph = 0; ph < NPH; ++ph) { a.ph_lo = ph; a.ph_hi = ph + 1; a.coop = 0; hipLaunchKernelGGL(mega, dim3(grid), dim3(512), LDS_BYTES, stream, a); }
#else
    a.ph_lo = 0; a.ph_hi = NPH; a.coop = 1;
    void* kargs[] = {&a};
    hipError_t e = hipLaunchCooperativeKernel((const void*)mega, dim3(grid), dim3(512), kargs, LDS_BYTES, stream);
    if (e != hipSuccess) fprintf(stderr, "cooperative launch failed: %s (grid %d)\n", hipGetErrorString(e), grid);
#endif
}
```

```cpp
#include <hip/hip_runtime.h>
#include <hip/hip_cooperative_groups.h>
#include <cstdint>
#include <cstdio>
namespace cg = cooperative_groups;

#ifndef MK_MULTI
#define MK_MULTI 0
#endif

#ifndef REP_MASK
#define REP_MASK 0
#endif
#define LAS __attribute__((address_space(3)))
typedef unsigned short bf16_t;
typedef short bf16x8 __attribute__((ext_vector_type(8)));
typedef short s16x4 __attribute__((ext_vector_type(4)));
typedef float f32x4 __attribute__((ext_vector_type(4)));
typedef float f32x16 __attribute__((ext_vector_type(16)));
typedef unsigned u32x4 __attribute__((ext_vector_type(4)));
typedef unsigned u32x2 __attribute__((ext_vector_type(2)));

constexpr int DM = 1024, NCTX = 16 * 256, NLAT = 2 * 4096, T = NCTX + NLAT;
constexpr int DEPTH = 4, PAST = 256, LKV = PAST + 4096;
constexpr int INW = 8768, PW = 8704, INWP = 8960;
constexpr int DFF = 2816, UPW = 5632, DIN = 2048, XBCW = 3072;
constexpr int PC_Q = 0, PC_K = 1024, PC_V = 1280, PC_Z = 1536, PC_XBC = 3584, PC_GA = 6656, PC_GS = 7680;
constexpr float EPS = 1e-6f;

constexpr size_t MiB = 1u << 20;
constexpr size_t WS_CTL = 0;
constexpr size_t WS_MOD = 1 * MiB;
constexpr size_t WS_ROPE = 1 * MiB + 512 * 1024;
constexpr size_t WS_W = 2 * MiB;
constexpr size_t W_IN = 0, W_AO = (size_t)INWP * 1024, W_SO = W_AO + 1024 * 1024, W_OUT = W_SO + 1024 * 2048, W_UP = W_OUT + 1024 * 1024, W_DN = W_UP + (size_t)UPW * 1024, W_END = W_DN + (size_t)1024 * DFF;
constexpr size_t WS_WSTRIDE = 43 * MiB;
constexpr size_t WS_P = 88 * MiB;
constexpr size_t WS_H = 294 * MiB;
constexpr size_t WS_Q = 318 * MiB;
constexpr size_t WS_AO = WS_Q;
constexpr size_t WS_K = 342 * MiB;
constexpr size_t WS_V = 349 * MiB;
constexpr size_t WS_XBC = 356 * MiB;
constexpr size_t WS_YF = 428 * MiB;
constexpr size_t WS_YB = 476 * MiB;
constexpr size_t WS_DTR = 524 * MiB;
constexpr size_t WS_DTV = 527 * MiB;
constexpr size_t WS_CUM = 530 * MiB;
constexpr size_t WS_END = 533 * MiB;
static_assert(WS_W + 2 * WS_WSTRIDE <= WS_P, "weight buffers");
static_assert(W_END * 2 <= WS_WSTRIDE, "weights");
constexpr size_t O_X = 0, O_CK = (size_t)T * DM, O_CV = O_CK + (size_t)16 * 4 * 256 * 256, O_ST = O_CV + (size_t)16 * 4 * 256 * 256;

constexpr int LDS_BYTES = 147456;
constexpr int NPH_LAYER = 11, NPH = 1 + DEPTH * NPH_LAYER;

struct Args { const float* in[25]; float* out; unsigned char* ws; int ph_lo, ph_hi, coop, pad; };
enum { I_XP = 0, I_XS, I_C, I_CK, I_CV, I_ST, I_CCTX, I_WMOD, I_BMOD, I_WIN, I_QN, I_KN, I_CONVW, I_CONVB, I_DTB, I_ALOG, I_DSKIP, I_SSDN, I_WAO, I_WSO, I_WOUT, I_WUP, I_FCW, I_FCB, I_WDN };

typedef float f32x2_t __attribute__((ext_vector_type(2))); typedef __bf16 bf16x2_t __attribute__((ext_vector_type(2)));
__device__ __forceinline__ unsigned cvtpk(float lo, float hi) { f32x2_t v = {lo, hi}; bf16x2_t b = __builtin_convertvector(v, bf16x2_t); return __builtin_bit_cast(unsigned, b); }
__device__ __forceinline__ float bf2f(unsigned short b) { return __uint_as_float((unsigned)b << 16); }
__device__ __forceinline__ float bflo(unsigned w) { return __uint_as_float(w << 16); }
__device__ __forceinline__ float bfhi(unsigned w) { return __uint_as_float(w & 0xffff0000u); }
__device__ __forceinline__ void unpack8(u32x4 w, float* f) { f[0] = bflo(w.x); f[1] = bfhi(w.x); f[2] = bflo(w.y); f[3] = bfhi(w.y); f[4] = bflo(w.z); f[5] = bfhi(w.z); f[6] = bflo(w.w); f[7] = bfhi(w.w); }
__device__ __forceinline__ u32x4 pack8(const float* f) { u32x4 w; w.x = cvtpk(f[0], f[1]); w.y = cvtpk(f[2], f[3]); w.z = cvtpk(f[4], f[5]); w.w = cvtpk(f[6], f[7]); return w; }
__device__ __forceinline__ u32x4 zero4() { u32x4 z = {0u, 0u, 0u, 0u}; asm volatile("" : "+v"(z)); return z; }
__device__ __forceinline__ float sigmoidf_(float x) { return __builtin_amdgcn_rcpf(1.f + __expf(-x)); }
__device__ __forceinline__ float siluf_(float x) { return x * __builtin_amdgcn_rcpf(1.f + __expf(-x)); }
__device__ __forceinline__ float wave_sum(float v) {
#pragma unroll
    for (int o = 1; o < 64; o <<= 1) v += __shfl_xor(v, o);
    return v;
}
__device__ __forceinline__ int fresh_tid(int wid) { int ln; asm volatile("v_mbcnt_lo_u32_b32 %0, -1, 0\n\tv_mbcnt_hi_u32_b32 %0, -1, %0" : "=v"(ln)); return wid * 64 + ln; }
__device__ __forceinline__ int mod_idx(int t) { return t < NCTX ? 0 : 1 + ((t - NCTX) >> 12); }

namespace gm {
constexpr int BM = 256, BK = 64, HALF = 128, HTB = HALF * BK * 2, NXCD = 8, WGM = 8;
__device__ __forceinline__ int lds_byte(int r, int c) { const int st = (r >> 4) * 2 + (c >> 5), rr = r & 15, cc = c & 31, ob = rr * 64 + cc * 2; return st * 1024 + (ob ^ (((ob >> 9) & 1) << 5)); }
__device__ __forceinline__ void stage_rc(int b, int& R, int& C) { const int st = b / 1024, sb = b % 1024, swz = sb ^ (((sb >> 9) & 1) << 5); R = (st >> 1) * 16 + swz / 64; C = (st & 1) * 32 + (swz % 64) / 2; }
__device__ __forceinline__ void tile_of(int L, int nM, int nN, int& pm, int& pn) {
    const int nwg = nM * nN; int wgid = L;
    { const int q = nwg / NXCD, r = nwg % NXCD, xcd = wgid % NXCD, off = wgid / NXCD; wgid = (xcd < r ? xcd * (q + 1) : r * (q + 1) + (xcd - r) * q) + off; }
    const int nig = WGM * nN, gid = wgid / nig, fm = gid * WGM, gsz = (nM - fm) < WGM ? (nM - fm) : WGM;
    pm = fm + ((wgid % nig) % gsz); pn = (wgid % nig) / gsz;
}
typedef f32x4 Acc[2][2][4][2];
__device__ __forceinline__ void zero_acc(Acc& acc) {
#pragma unroll
    for (int a = 0; a < 2; ++a)
#pragma unroll
        for (int b = 0; b < 2; ++b)
#pragma unroll
            for (int m = 0; m < 4; ++m)
#pragma unroll
                for (int n = 0; n < 2; ++n) acc[a][b][m][n] = (f32x4){0.f, 0.f, 0.f, 0.f};
}
__device__ __forceinline__ void kloop(LAS unsigned char* lds, int tid, const bf16_t* A, int lda, const bf16_t* Bt, int ldb, int K, Acc& acc) {
    const int wid = __builtin_amdgcn_readfirstlane(tid >> 6), lane = tid & 63, wr = wid >> 2, wc = wid & 3, fr = lane & 15, fq = lane >> 4;
    unsigned voffA[2], voffB[2];
#pragma unroll
    for (int i = 0; i < 2; ++i) { int R, C; stage_rc(tid * 16 + i * 8192, R, C); voffA[i] = (unsigned)(R * lda + C) * 2u; voffB[i] = (unsigned)(R * ldb + C) * 2u; }
    const char* cA = (const char*)A; const char* cB = (const char*)Bt;
    const size_t hA = (size_t)HALF * lda * 2, hB = (size_t)HALF * ldb * 2; const size_t ks = BK * 2;
    const unsigned ldsw = (unsigned)wid * 1024u;
    const int aoff = lds_byte(wr * 64 + fr, fq * 8), boff = lds_byte(wc * 32 + fr, fq * 8);
    const int nt = K / BK;
#define SA_(b, h) (((b) * 2 + (h)) * HTB)
#define SB_(b, h) ((4 + (b) * 2 + (h)) * HTB)
#define STAGE(bufoff, gbase, voff) do { _Pragma("unroll") for (int _i = 0; _i < 2; ++_i) \
        __builtin_amdgcn_global_load_lds((const unsigned*)((const char*)(gbase) + (voff)[_i]), (LAS unsigned*)(lds + (bufoff) + ldsw + _i * 8192), 16, 0, 0); } while (0)
#define LDA(dst, b, h) do { _Pragma("unroll") for (int m = 0; m < 4; ++m) _Pragma("unroll") for (int k = 0; k < 2; ++k) dst[m][k] = *(const LAS bf16x8*)(lds + SA_(b, h) + aoff + m * 2048 + k * 1024); } while (0)
#define LDB(dst, b, h) do { _Pragma("unroll") for (int n = 0; n < 2; ++n) _Pragma("unroll") for (int k = 0; k < 2; ++k) dst[n][k] = *(const LAS bf16x8*)(lds + SB_(b, h) + boff + n * 2048 + k * 1024); } while (0)
#define MMA(ai, bj, At, Bt_) do { __builtin_amdgcn_s_setprio(1); _Pragma("unroll") for (int m = 0; m < 4; ++m) _Pragma("unroll") for (int n = 0; n < 2; ++n) _Pragma("unroll") for (int k = 0; k < 2; ++k) \
        acc[ai][bj][m][n] = __builtin_amdgcn_mfma_f32_16x16x32_bf16(Bt_[n][k], At[m][k], acc[ai][bj][m][n], 0, 0, 0); __builtin_amdgcn_s_setprio(0); } while (0)
#define WAIT_V(n) asm volatile("s_waitcnt vmcnt(" #n ")" ::: "memory")
#define WAIT_L(n) asm volatile("s_waitcnt lgkmcnt(" #n ")" ::: "memory")
#define BAR __builtin_amdgcn_s_barrier()
#define SCHED __builtin_amdgcn_sched_barrier(0)
    bf16x8 At[4][2], B0[2][2], B1[2][2];
    STAGE(SB_(0, 0), cB, voffB); STAGE(SA_(0, 0), cA, voffA); STAGE(SB_(0, 1), cB + hB, voffB); STAGE(SA_(0, 1), cA + hA, voffA);
    if (wr == 1) BAR;
    WAIT_V(4); BAR;
    STAGE(SB_(1, 0), cB + ks, voffB); STAGE(SA_(1, 0), cA + ks, voffA); STAGE(SB_(1, 1), cB + hB + ks, voffB);
    WAIT_V(6); BAR;
    for (int t = 0; t < nt - 2; t += 2) {
        const char* a1 = cA + (size_t)(t + 1) * ks; const char* a2 = cA + (size_t)(t + 2) * ks; const char* b2 = cB + (size_t)(t + 2) * ks;
        const char* a3 = a2 + ks; const char* b3 = b2 + ks;
        LDB(B0, 0, 0); SCHED; LDA(At, 0, 0); STAGE(SA_(1, 1), a1 + hA, voffA);
        WAIT_L(8); BAR; WAIT_L(0); MMA(0, 0, At, B0); BAR; SCHED;
        LDB(B1, 0, 1); STAGE(SB_(0, 0), b2, voffB);
        BAR; WAIT_L(0); MMA(0, 1, At, B1); BAR;
        LDA(At, 0, 1); STAGE(SA_(0, 0), a2, voffA);
        BAR; WAIT_L(0); MMA(1, 0, At, B0); BAR; SCHED;
        STAGE(SB_(0, 1), b2 + hB, voffB);
        WAIT_V(6); BAR; MMA(1, 1, At, B1); BAR;
        LDB(B0, 1, 0); SCHED; LDA(At, 1, 0); STAGE(SA_(0, 1), a2 + hA, voffA);
        WAIT_L(8); BAR; WAIT_L(0); MMA(0, 0, At, B0); BAR; SCHED;
        LDB(B1, 1, 1); STAGE(SB_(1, 0), b3, voffB);
        BAR; WAIT_L(0); MMA(0, 1, At, B1); BAR;
        LDA(At, 1, 1); STAGE(SA_(1, 0), a3, voffA);
        BAR; WAIT_L(0); MMA(1, 0, At, B0); BAR; SCHED;
        STAGE(SB_(1, 1), b3 + hB, voffB);
        WAIT_V(6); BAR; MMA(1, 1, At, B1); BAR;
    }
    { const char* a1 = cA + (size_t)(nt - 1) * ks;
      LDB(B0, 0, 0); LDA(At, 0, 0); STAGE(SA_(1, 1), a1 + hA, voffA);
      BAR; WAIT_L(0); MMA(0, 0, At, B0); BAR;
      LDB(B1, 0, 1); BAR; WAIT_L(0); MMA(0, 1, At, B1); BAR;
      LDA(At, 0, 1); WAIT_V(4); BAR; WAIT_L(0); MMA(1, 0, At, B0); MMA(1, 1, At, B1); BAR; }
    { LDB(B0, 1, 0); LDA(At, 1, 0); WAIT_V(2); BAR; WAIT_L(0); MMA(0, 0, At, B0); BAR;
      LDB(B1, 1, 1); WAIT_V(0); BAR; WAIT_L(0); MMA(0, 1, At, B1); BAR;
      LDA(At, 1, 1); BAR; WAIT_L(0); MMA(1, 0, At, B0); MMA(1, 1, At, B1); BAR; }
    if (wr == 0) BAR;
#undef SA_
#undef SB_
#undef STAGE
#undef LDA
#undef LDB
#undef MMA
#undef WAIT_V
#undef WAIT_L
#undef BAR
#undef SCHED
}
template <class F> __device__ __forceinline__ void for_acc(Acc& acc, int tid, int brow, int bcol, F f) {
    const int wid = tid >> 6, lane = tid & 63, wr = wid >> 2, wc = wid & 3, fr = lane & 15, fq = lane >> 4;
#pragma unroll
    for (int ai = 0; ai < 2; ++ai)
#pragma unroll
        for (int m = 0; m < 4; ++m) {
            const int row = brow + ai * HALF + wr * 64 + m * 16 + fr;
#pragma unroll
            for (int bj = 0; bj < 2; ++bj)
#pragma unroll
                for (int n = 0; n < 2; ++n) f(row, bcol + bj * HALF + wc * 32 + n * 16 + fq * 4, acc[ai][bj][m][n]);
            asm volatile("" ::: "memory");
        }
}
}

namespace at {
constexpr int D = 128, NW = 8, QBLK = 32, KVBLK = 64;
constexpr float SCALE = 0.088388347648318440f, THR = 8.f;
constexpr int LDQ = 1024, LDK = 256, LDO = 1024;
constexpr int SHM_V = KVBLK * D * 2, SHM_K = KVBLK * D * 2, SHM_ATTN = 2 * SHM_V + 2 * SHM_K + NW * 64 * 4;
#define KSWZ(row, colB) ((row) * 256 + ((colB) ^ (((row) & 7) << 4)))
#define SBAR() __builtin_amdgcn_sched_barrier(0)
__device__ __forceinline__ int crow(int r, int hi) { return (r & 3) + 8 * (r >> 2) + 4 * hi; }
__device__ __forceinline__ void partialSM(f32x16& p0, f32x16& p1, float& m_reg, float& mn, float& alpha) {
    constexpr float C = SCALE * 1.4426950408889634f;
    float pmax = p0[0];
#pragma unroll
    for (int r = 1; r < 16; ++r) pmax = fmaxf(pmax, p0[r]);
#pragma unroll
    for (int r = 0; r < 16; ++r) pmax = fmaxf(pmax, p1[r]);
    { auto rr = __builtin_amdgcn_permlane32_swap(__float_as_uint(pmax), __float_as_uint(pmax), false, false);
      pmax = fmaxf(__uint_as_float(rr[0]), __uint_as_float(rr[1])); }
    if (__builtin_expect(__all(pmax - m_reg <= THR / SCALE), 1)) { mn = m_reg; alpha = 1.f; }
    else { mn = fmaxf(m_reg, pmax); alpha = __builtin_amdgcn_exp2f((m_reg - mn) * C); m_reg = mn; }
    float mnC = -mn * C;
#pragma unroll
    for (int r = 0; r < 16; ++r) p0[r] = fmaf(p0[r], C, mnC);
#pragma unroll
    for (int r = 0; r < 16; ++r) p1[r] = fmaf(p1[r], C, mnC);
#pragma unroll
    for (int r = 0; r < 16; ++r) p0[r] = __builtin_amdgcn_exp2f(p0[r]);
}
__device__ __forceinline__ void finishSM(f32x16& p0, f32x16& p1, float alpha, float& l_reg, bf16x8& pa0, bf16x8& pa1, bf16x8& pa2, bf16x8& pa3) {
#pragma unroll
    for (int r = 0; r < 16; ++r) p1[r] = __builtin_amdgcn_exp2f(p1[r]);
    float ps = 0;
#pragma unroll
    for (int r = 0; r < 16; ++r) ps += p0[r];
#pragma unroll
    for (int r = 0; r < 16; ++r) ps += p1[r];
    { auto rr = __builtin_amdgcn_permlane32_swap(__float_as_uint(ps), __float_as_uint(ps), false, false);
      ps = __uint_as_float(rr[0]) + __uint_as_float(rr[1]); }
    l_reg = l_reg * alpha + ps;
#define PK4(P, BASE, OUT) do { unsigned a0 = cvtpk(P[BASE + 0], P[BASE + 1]), a1 = cvtpk(P[BASE + 2], P[BASE + 3]);   \
    unsigned b0 = cvtpk(P[BASE + 4], P[BASE + 5]), b1 = cvtpk(P[BASE + 6], P[BASE + 7]);                              \
    auto r0 = __builtin_amdgcn_permlane32_swap(a0, b0, false, false); auto r1 = __builtin_amdgcn_permlane32_swap(a1, b1, false, false); \
    u32x4 w = {r0[0], r1[0], r0[1], r1[1]}; OUT = *reinterpret_cast<bf16x8*>(&w); } while (0)
    PK4(p0, 0, pa0); PK4(p0, 8, pa1); PK4(p1, 0, pa2); PK4(p1, 8, pa3);
#undef PK4
}
__device__ __forceinline__ void qkt(f32x16& p0, f32x16& p1, const bf16_t* Ks, const bf16x8* qr, int r32, int hi) {
    p0 = f32x16{}; p1 = f32x16{};
#pragma unroll
    for (int d0 = 0; d0 < 8; ++d0) { int cb = (d0 * 16 + hi * 8) * 2;
        bf16x8 b0 = *reinterpret_cast<const bf16x8*>((const char*)Ks + KSWZ(r32, cb));
        bf16x8 b1 = *reinterpret_cast<const bf16x8*>((const char*)Ks + KSWZ(32 + r32, cb));
        p0 = __builtin_amdgcn_mfma_f32_32x32x16_bf16(b0, qr[d0], p0, 0, 0, 0);
        p1 = __builtin_amdgcn_mfma_f32_32x32x16_bf16(b1, qr[d0], p1, 0, 0, 0); }
}
__device__ __forceinline__ int v_st(int k, int c) { const int kk = (k & ~0xC) | ((k & 4) << 1) | ((k & 8) >> 1); return ((kk >> 3) * 4 + (c >> 5)) * 512 + ((kk & 7) * 32 + (c & 31)) * 2; }
__device__ __forceinline__ int v_rd_base(int lane) { return ((lane & 3) << 3) | (((lane >> 2) & 3) << 6) | (((lane >> 4) & 1) << 5) | (((lane >> 5) & 1) << 8); }
constexpr int v_rd_off(int d0, int ks, int half) { return d0 * 512 + ks * 4096 + half * 2048; }
template <int OFF> __device__ __forceinline__ s16x4 tr_read(int vb) {
    s16x4 r; asm volatile("ds_read_b64_tr_b16 %0, %1 offset:%2" : "=&v"(r) : "v"(vb), "i"(OFF) : "memory"); return r;
}
template <int D0> __device__ __forceinline__ void pv_one(f32x16& od, int vb, bf16x8 pa0, bf16x8 pa1, bf16x8 pa2, bf16x8 pa3) {
    const s16x4 l0 = tr_read<v_rd_off(D0, 0, 0)>(vb), h0 = tr_read<v_rd_off(D0, 0, 1)>(vb), l1 = tr_read<v_rd_off(D0, 1, 0)>(vb), h1 = tr_read<v_rd_off(D0, 1, 1)>(vb);
    const s16x4 l2 = tr_read<v_rd_off(D0, 2, 0)>(vb), h2 = tr_read<v_rd_off(D0, 2, 1)>(vb), l3 = tr_read<v_rd_off(D0, 3, 0)>(vb), h3 = tr_read<v_rd_off(D0, 3, 1)>(vb);
    asm volatile("s_waitcnt lgkmcnt(0)" ::: "memory"); SBAR();
#define PK(L, H) (bf16x8){L[0], L[1], L[2], L[3], H[0], H[1], H[2], H[3]}
    od = __builtin_amdgcn_mfma_f32_32x32x16_bf16(pa0, PK(l0, h0), od, 0, 0, 0);
    od = __builtin_amdgcn_mfma_f32_32x32x16_bf16(pa1, PK(l1, h1), od, 0, 0, 0);
    od = __builtin_amdgcn_mfma_f32_32x32x16_bf16(pa2, PK(l2, h2), od, 0, 0, 0);
    od = __builtin_amdgcn_mfma_f32_32x32x16_bf16(pa3, PK(l3, h3), od, 0, 0, 0);
#undef PK
}
__device__ __forceinline__ void pv_d0(f32x16* o, int vb, bf16x8 pa0, bf16x8 pa1, bf16x8 pa2, bf16x8 pa3) {
    pv_one<0>(o[0], vb, pa0, pa1, pa2, pa3); pv_one<1>(o[1], vb, pa0, pa1, pa2, pa3); pv_one<2>(o[2], vb, pa0, pa1, pa2, pa3); pv_one<3>(o[3], vb, pa0, pa1, pa2, pa3);
}
__device__ __forceinline__ void attn_body(const bf16_t* __restrict__ Qb, const bf16_t* __restrict__ Kh, const bf16_t* __restrict__ Vh, bf16_t* __restrict__ Ob, int seq, char* lds, int tid) {
    const int wid = tid >> 6, lane = tid & 63, r32 = lane & 31, hi = lane >> 5;
    bf16_t* V_lds = (bf16_t*)lds; bf16_t* K_lds = (bf16_t*)(lds + 2 * SHM_V);
    float* ws = (float*)(lds + 2 * SHM_V + 2 * SHM_K) + wid * 64; float* li_l = ws; float* al_l = ws + 32;
    float m_reg = -1e30f, l_reg = 0; f32x16 o[4] = {}; bf16x8 qr[8];
    const bf16_t* Qw = Qb + (long)(wid * QBLK + r32) * LDQ + hi * 8;
#pragma unroll
    for (int d0 = 0; d0 < 8; ++d0) qr[d0] = *reinterpret_cast<const bf16x8*>(Qw + d0 * 16);
    const int sr = tid >> 4, sc = (tid & 15) * 8, vst0 = v_st(sr, sc), vst1 = v_st(32 + sr, sc);
    const int vb0 = (int)(uintptr_t)V_lds + v_rd_base(lane);
    struct { bf16x8 vs0, vs1, ks0, ks1; } sr_[2];
#define SLOAD(i, k0) do { sr_[i].vs0 = *(const bf16x8*)(&Vh[(long)((k0) + sr) * LDK + sc]); sr_[i].vs1 = *(const bf16x8*)(&Vh[(long)((k0) + 32 + sr) * LDK + sc]); \
    sr_[i].ks0 = *(const bf16x8*)(&Kh[(long)((k0) + sr) * LDK + sc]); sr_[i].ks1 = *(const bf16x8*)(&Kh[(long)((k0) + 32 + sr) * LDK + sc]); } while (0)
#define SWRITE(b, i) do { *(bf16x8*)((char*)V_lds + (b) * SHM_V + vst0) = sr_[i].vs0;          \
    *(bf16x8*)((char*)V_lds + (b) * SHM_V + vst1) = sr_[i].vs1; int kc = sc * 2;               \
    *(bf16x8*)((char*)K_lds + (b) * SHM_K + KSWZ(sr, kc)) = sr_[i].ks0;                       \
    *(bf16x8*)((char*)K_lds + (b) * SHM_K + KSWZ(32 + sr, kc)) = sr_[i].ks1; } while (0)
#define SWAIT() asm volatile("s_waitcnt vmcnt(4)" ::: "memory")
#define RESC(a) do { if (__any((a) < 1.f)) { if (hi == 0) al_l[r32] = (a); asm volatile("s_waitcnt lgkmcnt(0)" ::: "memory"); \
    _Pragma("unroll") for (int d = 0; d < 4; ++d) _Pragma("unroll") for (int r = 0; r < 16; ++r) o[d][r] *= al_l[crow(r, hi)]; } } while (0)
    f32x16 pA0, pA1, pB0, pB1; float mnA, mnB, alA, alB; bf16x8 pa0, pa1, pa2, pa3; const int NT = seq / KVBLK;
    constexpr int SE = 0, SO = 1;
    SLOAD(SE, 0); asm volatile("s_waitcnt vmcnt(0)" ::: "memory"); SWRITE(0, SE); __syncthreads();
    qkt(pA0, pA1, K_lds, qr, r32, hi); partialSM(pA0, pA1, m_reg, mnA, alA);
    SLOAD(SO, KVBLK); if (2 < NT) SLOAD(SE, 2 * KVBLK);
    SWAIT(); SWRITE(1, SO); __syncthreads();
    for (int j = 1; j + 1 < NT; j += 2) {
        SBAR(); qkt(pB0, pB1, (bf16_t*)((char*)K_lds + SHM_K), qr, r32, hi);
        finishSM(pA0, pA1, alA, l_reg, pa0, pa1, pa2, pa3); SBAR();
        SLOAD(SO, (j + 2) * KVBLK); SBAR();
        pv_d0(o, vb0, pa0, pa1, pa2, pa3); partialSM(pB0, pB1, m_reg, mnB, alB);
        __syncthreads(); SWAIT(); SWRITE(0, SE);
        RESC(alB); __syncthreads();
        SBAR(); qkt(pA0, pA1, K_lds, qr, r32, hi);
        finishSM(pB0, pB1, alB, l_reg, pa0, pa1, pa2, pa3); SBAR();
        if (j + 3 < NT) SLOAD(SE, (j + 3) * KVBLK); SBAR();
        pv_d0(o, vb0 + (int)SHM_V, pa0, pa1, pa2, pa3); partialSM(pA0, pA1, m_reg, mnA, alA);
        __syncthreads(); SWAIT(); SWRITE(1, SO);
        RESC(alA); __syncthreads();
    }
    SBAR(); qkt(pB0, pB1, (bf16_t*)((char*)K_lds + SHM_K), qr, r32, hi);
    finishSM(pA0, pA1, alA, l_reg, pa0, pa1, pa2, pa3); SBAR();
    pv_d0(o, vb0, pa0, pa1, pa2, pa3); partialSM(pB0, pB1, m_reg, mnB, alB);
    __syncthreads(); RESC(alB);
    finishSM(pB0, pB1, alB, l_reg, pa0, pa1, pa2, pa3); SBAR();
    pv_d0(o, vb0 + (int)SHM_V, pa0, pa1, pa2, pa3);
    if (hi == 0) li_l[r32] = l_reg; asm volatile("s_waitcnt lgkmcnt(0)" ::: "memory");
    float rli[16];
#pragma unroll
    for (int r = 0; r < 16; ++r) rli[r] = __builtin_amdgcn_rcpf(li_l[crow(r, hi)]);
    bf16_t* Ow = Ob + (long)(wid * QBLK) * LDO;
#pragma unroll
    for (int r = 0; r < 16; ++r) { int orow = crow(r, hi);
#pragma unroll
        for (int d0 = 0; d0 < 4; ++d0) Ow[(long)orow * LDO + d0 * 32 + r32] = (bf16_t)(cvtpk(o[d0][r] * rli[r], 0.f) & 0xffffu); }
    __syncthreads();
#undef SLOAD
#undef SWRITE
#undef SWAIT
#undef RESC
}
#undef KSWZ
#undef SBAR
}

typedef __attribute__((address_space(4))) const Args CArgs;
typedef CArgs* ArgsP;
struct Ctx {
    ArgsP a; LAS unsigned char* lds; char* ldsg; int tid, lane, wid, gw, ngw;
};

__device__ __forceinline__ unsigned f2bf(float f) { unsigned u = __float_as_uint(f); return (u + 0x7fffu + ((u >> 16) & 1u)) >> 16; }
__device__ __forceinline__ unsigned pk2(float lo, float hi) { return f2bf(lo) | (f2bf(hi) << 16); }
__device__ __forceinline__ void transpose_item(const float* W, int K, int N, bf16_t* WT, LAS float* scr, int item, int lane, bool remap) {
    const int nblk = N / 32, kb = item / nblk, nb = item % nblk, k0 = 64 * kb, n0 = 32 * nb;
    int r0 = n0;
    if (remap) r0 = (n0 < 6656) ? n0 : (n0 < 6720 ? n0 - 6656 + 8704 : n0 - 64);
    float tv[32];
#pragma unroll
    for (int i = 0; i < 32; ++i) { const int kk = 2 * i + (lane >> 5); tv[i] = __builtin_nontemporal_load(&W[(size_t)(k0 + kk) * N + n0 + (lane & 31)]); }
#pragma unroll
    for (int i = 0; i < 32; ++i) { const int kk = 2 * i + (lane >> 5); scr[kk * 33 + (lane & 31)] = tv[i]; }
    asm volatile("s_waitcnt lgkmcnt(0)" ::: "memory");
    const int c = lane & 7;
#pragma unroll
    for (int j = 0; j < 4; ++j) { const int n = (lane >> 3) + 8 * j; const LAS float* s = scr + (8 * c) * 33 + n;
        u32x4 o; o.x = pk2(s[0 * 33], s[1 * 33]); o.y = pk2(s[2 * 33], s[3 * 33]); o.z = pk2(s[4 * 33], s[5 * 33]); o.w = pk2(s[6 * 33], s[7 * 33]);
        *(u32x4*)(WT + (size_t)(r0 + n) * K + k0 + 8 * c) = o; }
    asm volatile("s_waitcnt lgkmcnt(0)" ::: "memory");
}
__device__ __forceinline__ void convert_weights(const Ctx& c, int l, int gw, int ngw) {
    CArgs& a = *c.a; bf16_t* W = (bf16_t*)(a.ws + WS_W + (size_t)(l & 1) * WS_WSTRIDE);
    LAS float* scr = (LAS float*)(c.lds + c.wid * 16384);
    constexpr int I_IN = 16 * (INW / 32), I_AO = 16 * 32, I_SO = 32 * 32, I_OUT = 16 * 32, I_UP = 16 * (UPW / 32), I_DN = (DFF / 64) * 32;
    constexpr int NIT = I_IN + I_AO + I_SO + I_OUT + I_UP + I_DN;
    for (int it = gw; it < NIT; it += ngw) {
        int r = it;
        if (r < I_IN) { transpose_item(a.in[I_WIN] + (size_t)l * 1024 * INW, 1024, INW, W + W_IN, scr, r, c.lane, true); continue; } r -= I_IN;
        if (r < I_AO) { transpose_item(a.in[I_WAO] + (size_t)l * 1024 * 1024, 1024, 1024, W + W_AO, scr, r, c.lane, false); continue; } r -= I_AO;
        if (r < I_SO) { transpose_item(a.in[I_WSO] + (size_t)l * 2048 * 1024, 2048, 1024, W + W_SO, scr, r, c.lane, false); continue; } r -= I_SO;
        if (r < I_OUT) { transpose_item(a.in[I_WOUT] + (size_t)l * 1024 * 1024, 1024, 1024, W + W_OUT, scr, r, c.lane, false); continue; } r -= I_OUT;
        if (r < I_UP) { transpose_item(a.in[I_WUP] + (size_t)l * 1024 * UPW, 1024, UPW, W + W_UP, scr, r, c.lane, false); continue; } r -= I_UP;
        transpose_item(a.in[I_WDN] + (size_t)l * DFF * 1024, DFF, 1024, W + W_DN, scr, r, c.lane, false);
    }
    for (int i = gw * 64 + c.lane; i < 192 * 1024 / 8; i += ngw * 64) *(u32x4*)(W + W_IN + (size_t)8768 * 1024 + (size_t)i * 8) = zero4();
}

__device__ __forceinline__ void modulate_phase(const Ctx& c, int l, int which) {
    CArgs& a = *c.a; const float* x = a.out + O_X; bf16_t* H = (bf16_t*)(a.ws + WS_H);
    const float* modl = (const float*)(a.ws + WS_MOD) + (size_t)l * 3 * 6144;
    for (int t = c.gw; t < T; t += c.ngw) {
        const float* md = modl + mod_idx(t) * 6144 + which * 3072; const float* sh = md; const float* sc = md + 1024;
        const f32x4* xr = (const f32x4*)(x + (size_t)t * DM);
        f32x4 v[4]; float s = 0.f;
#pragma unroll
        for (int j = 0; j < 4; ++j) { v[j] = xr[c.lane + 64 * j]; s += v[j].x * v[j].x + v[j].y * v[j].y + v[j].z * v[j].z + v[j].w * v[j].w; }
        const float rstd = rsqrtf(wave_sum(s) * (1.f / DM) + EPS);
#pragma unroll
        for (int j = 0; j < 4; ++j) { const int col = (c.lane + 64 * j) * 4; const f32x4 scv = *(const f32x4*)(sc + col), shv = *(const f32x4*)(sh + col);
            const f32x4 o = v[j] * rstd * (scv + 1.f) + shv; u32x2 w; w.x = cvtpk(o.x, o.y); w.y = cvtpk(o.z, o.w);
            *(u32x2*)(H + (size_t)t * DM + col) = w; }
    }
}

__device__ __forceinline__ void setup_phase(const Ctx& c) {
    CArgs& a = *c.a;
    { const int g = blockIdx.x * 512 + c.tid;
      if (g < 2048) { const int pos = g >> 5, i = g & 31; const float inv = __builtin_amdgcn_exp2f(-(float)i * (13.287712379549449f / 32.0f)); const float ang = (float)pos * inv;
          float* rt = (float*)(a.ws + WS_ROPE); rt[g] = __cosf(ang); rt[2048 + g] = __sinf(ang); } }
    LAS float* sl = (LAS float*)c.lds; LAS float* red = (LAS float*)(c.lds + 12288);
    for (int i = c.tid; i < 3072; i += 512) { const int s = i >> 10, k = i & 1023; const float cv = s == 0 ? a.in[I_CCTX][k] : a.in[I_C][(s - 1) * 1024 + k]; sl[i] = siluf_(cv); }
    __syncthreads();
    float* mod = (float*)(a.ws + WS_MOD);
    for (int item = blockIdx.x; item < 192; item += gridDim.x) {
        const int l = item / 48, cb = (item % 48) >> 1, kh = item & 1, col = cb * 256 + c.lane * 4, k0 = kh * 512 + c.wid * 64;
        f32x4 acc[3] = {{0.f, 0.f, 0.f, 0.f}, {0.f, 0.f, 0.f, 0.f}, {0.f, 0.f, 0.f, 0.f}};
        const float* wp = a.in[I_WMOD] + ((size_t)l * 1024 + k0) * 6144 + col;
#pragma unroll 16
        for (int k = 0; k < 64; ++k) { const f32x4 w = __builtin_nontemporal_load((const f32x4*)(wp + (size_t)k * 6144));
            acc[0] += w * sl[k0 + k]; acc[1] += w * sl[1024 + k0 + k]; acc[2] += w * sl[2048 + k0 + k]; }
#pragma unroll
        for (int s = 0; s < 3; ++s) *(LAS f32x4*)(red + (c.wid * 3 + s) * 256 + c.lane * 4) = acc[s];
        __syncthreads();
        for (int e = c.tid; e < 768; e += 512) { const int s = e >> 8, cc = e & 255; float v = kh == 0 ? a.in[I_BMOD][(size_t)l * 6144 + cb * 256 + cc] : 0.f;
#pragma unroll
            for (int w = 0; w < 8; ++w) v += red[(w * 3 + s) * 256 + cc];
            atomicAdd(&mod[((size_t)l * 3 + s) * 6144 + cb * 256 + cc], v); }
        __syncthreads();
    }
    { const f32x4* xp = (const f32x4*)a.in[I_XP]; const f32x4* xs = (const f32x4*)a.in[I_XS]; f32x4* o = (f32x4*)(a.out + O_X);
      const size_t n1 = (size_t)NCTX * DM / 4, n = (size_t)T * DM / 4, st = (size_t)gridDim.x * 512;
      for (size_t i = (size_t)blockIdx.x * 512 + c.tid; i < n; i += 4 * st) {
          f32x4 v[4];
#pragma unroll
          for (int u = 0; u < 4; ++u) { const size_t j = i + u * st; if (j < n) v[u] = j < n1 ? xp[j] : xs[j - n1]; }
#pragma unroll
          for (int u = 0; u < 4; ++u) { const size_t j = i + u * st; if (j < n) o[j] = v[u]; } } }
    convert_weights(c, 0, c.gw, c.ngw);
}

__device__ __forceinline__ void e2_phase(const Ctx& c, int l) {
    CArgs& a = *c.a;
    const bf16_t* P = (const bf16_t*)(a.ws + WS_P); bf16_t* Q = (bf16_t*)(a.ws + WS_Q); bf16_t* KB = (bf16_t*)(a.ws + WS_K); bf16_t* VB = (bf16_t*)(a.ws + WS_V);
    bf16_t* XB = (bf16_t*)(a.ws + WS_XBC);
    const float* rt = (const float*)(a.ws + WS_ROPE);
    const int lane = c.lane;
    constexpr int NT_DT = 96 * 16, NT_CACHE = 512, NRUN = T / 32, NT_TOK = NRUN * 9;
    for (int id = c.gw; id < NT_DT + NT_CACHE + NT_TOK; id += c.ngw) {
        if (id < NT_DT) {
            const int chk = id >> 4, col = (id & 15) * 4 + (lane >> 4), rg = lane & 15, dir = col >> 5, row0 = chk * 128;
            const float bias = a.in[I_DTB][l * 64 + col], av = -__expf(a.in[I_ALOG][l * 64 + col]);
            const float* dr = (const float*)(a.ws + WS_DTR); float* dv = (float*)(a.ws + WS_DTV); float* cm = (float*)(a.ws + WS_CUM);
            float d[8], cs[8];
#pragma unroll
            for (int e = 0; e < 8; ++e) { const int i = rg * 8 + e, row = row0 + (dir ? 127 - i : i); d[e] = dr[(size_t)row * 64 + col] + bias; }
            float run = 0.f;
#pragma unroll
            for (int e = 0; e < 8; ++e) { const float xr = d[e]; d[e] = xr > 20.f ? xr : log1pf(__expf(xr)); run += d[e] * av; cs[e] = run; }
            float inc = run;
#pragma unroll
            for (int o = 1; o < 16; o <<= 1) { const float t = __shfl_up(inc, o, 16); if (rg >= o) inc += t; }
            const float off = inc - run;
#pragma unroll
            for (int e = 0; e < 8; ++e) { const int i = rg * 8 + e, row = row0 + (dir ? 127 - i : i); dv[(size_t)row * 64 + col] = d[e]; cm[(size_t)row * 64 + col] = cs[e] + off; }
            continue;
        }
        if (id < NT_DT + NT_CACHE) {
            const int r = id - NT_DT, b = r >> 8, j = r & 255; const bool isv = lane >= 32; const int li = lane & 31;
            const float* src = a.in[isv ? I_CV : I_CK] + (((size_t)b * DEPTH + l) * PAST + j) * 256 + li * 8;
            const f32x4 v0 = *(const f32x4*)src, v1 = *(const f32x4*)(src + 4);
            u32x4 w; w.x = cvtpk(v0.x, v0.y); w.y = cvtpk(v0.z, v0.w); w.z = cvtpk(v1.x, v1.y); w.w = cvtpk(v1.z, v1.w);
            *(u32x4*)((isv ? VB : KB) + (size_t)(NCTX + b * LKV + j) * 256 + li * 8) = w;
            continue;
        }
        const int id2 = id - NT_DT - NT_CACHE;
        if (id2 < NRUN * 6) {
            const int run = id2 / 6, wt = id2 % 6, t0 = run * 32, c0 = (wt * 64 + lane) * 8;
            const bool lat = t0 >= NCTX; const int tt = lat ? t0 - NCTX : t0; const int pos0 = lat ? tt & 4095 : tt & 255, L = lat ? 4096 : 256;
            const float* cw = a.in[I_CONVW] + (size_t)l * 3 * XBCW + c0; const float* cbp = a.in[I_CONVB] + (size_t)l * XBCW + c0;
            float w0[8], w1[8], w2[8], bs[8];
#pragma unroll
            for (int e = 0; e < 8; ++e) { w0[e] = cw[e]; w1[e] = cw[XBCW + e]; w2[e] = cw[2 * XBCW + e]; bs[e] = cbp[e]; }
            const bf16_t* base = P + (size_t)t0 * PW + PC_XBC + c0; bf16_t* ob = XB + (size_t)t0 * XBCW + c0;
            const u32x4 zz = zero4();
            const bool tail_ok = pos0 + 32 < L;
            u32x4 R[10], N[8];
            R[0] = pos0 > 0 ? *(const u32x4*)(base - PW) : zz; R[1] = *(const u32x4*)base;
#pragma unroll
            for (int j = 0; j < 8; ++j) R[2 + j] = *(const u32x4*)(base + (size_t)(1 + j) * PW);
            for (int blk = 0; blk < 4; ++blk) {
                const int i0 = blk * 8;
                if (blk < 3) {
#pragma unroll
                    for (int j = 0; j < 8; ++j) { const int idx = i0 + 9 + j; N[j] = (idx < 32 || tail_ok) ? *(const u32x4*)(base + (size_t)idx * PW) : zz; }
                }
#pragma unroll
                for (int j = 0; j < 8; ++j) {
                    float xa[8], xb[8], xc[8], o[8]; unpack8(R[j], xa); unpack8(R[j + 1], xb); unpack8(R[j + 2], xc);
#pragma unroll
                    for (int e = 0; e < 8; ++e) o[e] = siluf_(bs[e] + w0[e] * xa[e] + w1[e] * xb[e] + w2[e] * xc[e]);
                    *(u32x4*)(ob + (size_t)(i0 + j) * XBCW) = pack8(o);
                }
                R[0] = R[8]; R[1] = R[9];
#pragma unroll
                for (int j = 0; j < 8; ++j) R[2 + j] = N[j];
            }
            continue;
        }
        const int id3 = id2 - NRUN * 6, run = id3 / 3, sub = id3 % 3, t0 = run * 32;
        const bool lat = t0 >= NCTX; const int tt0 = lat ? t0 - NCTX : t0; const int sb = lat ? tt0 >> 12 : tt0 >> 8, pos0 = lat ? tt0 & 4095 : tt0 & 255;
        const int li = lane & 15, d0 = li * 8; const int hq = sub * 4 + (lane >> 4);
        const bool isq = sub < 2, isv = !isq && lane >= 32; const int kvh = (lane >> 4) & 1;
        const int scol = isq ? PC_Q + hq * 128 + d0 : (isv ? PC_V : PC_K) + kvh * 128 + d0;
        float nwv[8];
        { const float* nw = a.in[isq ? I_QN : I_KN] + l * 128 + d0;
#pragma unroll
          for (int e = 0; e < 8; ++e) nwv[e] = nw[e]; }
        const bool first = (li & 7) < 4; const int fi = ((li & 3) * 8);
        const bf16_t* src0 = P + (size_t)t0 * PW + scol;
        for (int blk = 0; blk < 4; ++blk) {
        u32x4 RR[8];
#pragma unroll
        for (int j = 0; j < 8; ++j) RR[j] = *(const u32x4*)(src0 + (size_t)(blk * 8 + j) * PW);
#pragma unroll
        for (int j = 0; j < 8; ++j) {
            const int i = blk * 8 + j; const u32x4 cur = RR[j];
            const int t = t0 + i, pos = pos0 + i;
            float xv[8]; unpack8(cur, xv);
            float ss = 0.f;
#pragma unroll
            for (int e = 0; e < 8; ++e) ss += xv[e] * xv[e];
            ss += __shfl_xor(ss, 1); ss += __shfl_xor(ss, 2); ss += __shfl_xor(ss, 4); ss += __shfl_xor(ss, 8);
            const float rstd = rsqrtf(ss * (1.f / 128.f) + EPS);
            float y[8];
#pragma unroll
            for (int e = 0; e < 8; ++e) y[e] = isv ? xv[e] : xv[e] * rstd * nwv[e];
            const int pr = pos >> 6, pc = pos & 63; const int pp = (li >> 3) ? pc : pr;
            const f32x4 cs0 = *(const f32x4*)(rt + pp * 32 + fi), cs1 = *(const f32x4*)(rt + pp * 32 + fi + 4), sn0 = *(const f32x4*)(rt + 2048 + pp * 32 + fi), sn1 = *(const f32x4*)(rt + 2048 + pp * 32 + fi + 4);
            const float csv[8] = {cs0.x, cs0.y, cs0.z, cs0.w, cs1.x, cs1.y, cs1.z, cs1.w}, snv[8] = {sn0.x, sn0.y, sn0.z, sn0.w, sn1.x, sn1.y, sn1.z, sn1.w};
            float o[8];
#pragma unroll
            for (int e = 0; e < 8; ++e) { const float xp = __shfl_xor(y[e], 4); const float r = y[e] * csv[e] + (first ? -xp : xp) * snv[e]; o[e] = (lat && !isv) ? r : y[e]; }
            const u32x4 w = pack8(o);
            if (isq) { *(u32x4*)(Q + (size_t)t * DM + hq * 128 + d0) = w; }
            else {
                const size_t krow = lat ? (size_t)(NCTX + sb * LKV + PAST + pos) : (size_t)t;
                *(u32x4*)((isv ? VB : KB) + krow * 256 + kvh * 128 + d0) = w;
                if (!lat) { float* dst = a.out + (isv ? O_CV : O_CK) + (((size_t)sb * DEPTH + l) * 256 + pos) * 256 + kvh * 128 + d0;
                    *(f32x4*)dst = (f32x4){o[0], o[1], o[2], o[3]}; *(f32x4*)(dst + 4) = (f32x4){o[4], o[5], o[6], o[7]}; }
            }
        }
        }
    }
}

namespace sd {
constexpr int RS = 272, RSX = 160;
constexpr int L_C = 0, L_B = 128 * RS, L_X = 2 * 128 * RS, L_H0 = L_X + 128 * RSX, L_H1 = L_H0 + 64 * RS, L_CUM = L_H1 + 64 * RS, L_DT = L_CUM + 512, L_WG = L_DT + 512, L_Y = L_WG + 512, RSY = 144, L_END = L_Y + 128 * RSY;
static_assert(L_END <= 144 * 1024 - 256, "ssd lds");
typedef short v4i16_t __attribute__((ext_vector_type(4)));
__device__ __forceinline__ f32x4 mfma16(bf16x8 a, bf16x8 b, f32x4 c) { return __builtin_amdgcn_mfma_f32_16x16x32_bf16(a, b, c, 0, 0, 0); }
__device__ __forceinline__ bf16x8 tr_frag(LAS unsigned char* p, int rs) {
    const v4i16_t lo = __builtin_amdgcn_ds_read_tr16_b64_v4i16((LAS v4i16_t*)p), hi = __builtin_amdgcn_ds_read_tr16_b64_v4i16((LAS v4i16_t*)(p + 4 * rs));
    return (bf16x8){lo[0], lo[1], lo[2], lo[3], hi[0], hi[1], hi[2], hi[3]};
}
__device__ __forceinline__ void ssd_item(const Ctx& c, int l, int item) {
    CArgs& a = *c.a; LAS unsigned char* lds = c.lds;
    const int tid = c.tid, lane = c.lane, w = c.wid, fr = lane & 15, fq = lane >> 4, tq = (lane & 15) >> 2, tp = lane & 3;
    int sb, dir, h, row_base, nc; bool lat;
    if (item < 128) { lat = true; sb = item >> 6; dir = (item >> 5) & 1; h = item & 31; row_base = NCTX + sb * 4096; nc = 32; }
    else { const int it = item - 128; lat = false; sb = it >> 6; dir = (it >> 5) & 1; h = it & 31; row_base = sb * 256; nc = 2; }
    const int g = h >> 3, dcol = dir * 32 + h; const float dskv = a.in[I_DSKIP][l * 32 + h];
    const bf16_t* XB = (const bf16_t*)(a.ws + WS_XBC); bf16_t* Y = (bf16_t*)(a.ws + (dir ? WS_YB : WS_YF));
    const float* dv = (const float*)(a.ws + WS_DTV); const float* cm = (const float*)(a.ws + WS_CUM);
    f32x4 hacc[4];
    if (lat) { const float* st = a.in[I_ST] + ((((size_t)sb * DEPTH + l) * 2 + dir) * 32 + h) * 8192;
#pragma unroll
        for (int pt = 0; pt < 4; ++pt)
#pragma unroll
            for (int j = 0; j < 4; ++j) hacc[pt][j] = st[(16 * pt + 4 * fq + j) * 128 + 16 * w + fr]; }
    else {
#pragma unroll
        for (int pt = 0; pt < 4; ++pt) hacc[pt] = (f32x4){0.f, 0.f, 0.f, 0.f}; }
#pragma unroll
    for (int pt = 0; pt < 4; ++pt)
#pragma unroll
        for (int j = 0; j < 4; ++j) *(LAS bf16_t*)(lds + L_H0 + (16 * pt + 4 * fq + j) * RS + (16 * w + fr) * 2) = (bf16_t)(cvtpk(hacc[pt][j], 0.f) & 0xffffu);
    LAS float* cumS = (LAS float*)(lds + L_CUM); LAS float* dtS = (LAS float*)(lds + L_DT); LAS float* wgS = (LAS float*)(lds + L_WG);
    const int ll = tid & 127;
    u32x4 pcv[4], pbv[4], pxv[2]; float pcmr, pdvr, pclast;
#define SSD_LOAD(cs_) do { const int ch_ = dir ? nc - 1 - (cs_) : (cs_); const int r0_ = row_base + ch_ * 128; \
        pclast = cm[(size_t)(r0_ + (dir ? 0 : 127)) * 64 + dcol]; \
        { const int row_ = r0_ + (dir ? 127 - ll : ll); pcmr = cm[(size_t)row_ * 64 + dcol]; pdvr = dv[(size_t)row_ * 64 + dcol]; } \
        _Pragma("unroll") for (int i = 0; i < 4; ++i) { const int q_ = tid + 512 * i, l_ = q_ >> 4, cx = q_ & 15; const bf16_t* xr_ = XB + (size_t)(r0_ + (dir ? 127 - l_ : l_)) * XBCW; \
            pcv[i] = *(const u32x4*)(xr_ + 2560 + g * 128 + cx * 8); pbv[i] = *(const u32x4*)(xr_ + 2048 + g * 128 + cx * 8); } \
        _Pragma("unroll") for (int i = 0; i < 2; ++i) { const int q_ = tid + 512 * i, l_ = q_ >> 3, cx = q_ & 7; const bf16_t* xr_ = XB + (size_t)(r0_ + (dir ? 127 - l_ : l_)) * XBCW; \
            pxv[i] = *(const u32x4*)(xr_ + h * 64 + cx * 8); } } while (0)
    SSD_LOAD(0);
    const int xoff = L_X + (8 * fq + tq) * RSX + 8 * tp, boff = L_B + (8 * fq + tq) * RS + (16 * w) * 2 + 8 * tp;
    for (int cs = 0; cs < nc; ++cs) {
        const int ch = dir ? nc - 1 - cs : cs; const int r0 = row_base + ch * 128;
        const int hcur = (cs & 1) ? L_H1 : L_H0, hnxt = (cs & 1) ? L_H0 : L_H1;
        const float cum_last = pclast;
        if (tid < 128) { cumS[ll] = pcmr; dtS[ll] = pdvr; wgS[ll] = __expf(cum_last - pcmr) * pdvr; }
#pragma unroll
        for (int i = 0; i < 4; ++i) { const int q_ = tid + 512 * i, l_ = q_ >> 4, cx = q_ & 15; *(LAS u32x4*)(lds + L_C + l_ * RS + cx * 16) = pcv[i]; *(LAS u32x4*)(lds + L_B + l_ * RS + cx * 16) = pbv[i]; }
#pragma unroll
        for (int i = 0; i < 2; ++i) { const int q_ = tid + 512 * i, l_ = q_ >> 3, cx = q_ & 7; *(LAS u32x4*)(lds + L_X + l_ * RSX + cx * 16) = pxv[i]; }
        if (cs + 1 < nc) SSD_LOAD(cs + 1);
        asm volatile("s_waitcnt lgkmcnt(0)" ::: "memory"); __builtin_amdgcn_s_barrier(); asm volatile("" ::: "memory");
        bf16x8 cfr[4];
#pragma unroll
        for (int ks = 0; ks < 4; ++ks) cfr[ks] = *(const LAS bf16x8*)(lds + L_C + (16 * w + fr) * RS + ks * 64 + fq * 16);
        float cl[4];
#pragma unroll
        for (int j = 0; j < 4; ++j) cl[j] = cumS[16 * w + 4 * fq + j];
        for (int ct = 0; ct <= w; ct += 2) {
            f32x4 cb0 = (f32x4){0.f, 0.f, 0.f, 0.f}, cb1 = (f32x4){0.f, 0.f, 0.f, 0.f};
#pragma unroll
            for (int ks = 0; ks < 4; ++ks) { cb0 = mfma16(cfr[ks], *(const LAS bf16x8*)(lds + L_B + (16 * ct + fr) * RS + ks * 64 + fq * 16), cb0);
                                             cb1 = mfma16(cfr[ks], *(const LAS bf16x8*)(lds + L_B + (16 * ct + 16 + fr) * RS + ks * 64 + fq * 16), cb1); }
            const int s0 = 16 * ct + fr, s1 = s0 + 16; const float csv0 = cumS[s0], dts0 = dtS[s0], csv1 = cumS[s1], dts1 = dtS[s1];
#pragma unroll
            for (int j = 0; j < 4; ++j) { const int lrow = 16 * w + 4 * fq + j;
                const float wv0 = (s0 <= lrow) ? cb0[j] * __expf(cl[j] - csv0) * dts0 : 0.f, wv1 = (s1 <= lrow) ? cb1[j] * __expf(cl[j] - csv1) * dts1 : 0.f;
                *(LAS bf16_t*)(lds + L_C + lrow * RS + s0 * 2) = (bf16_t)(cvtpk(wv0, 0.f) & 0xffffu); *(LAS bf16_t*)(lds + L_C + lrow * RS + s1 * 2) = (bf16_t)(cvtpk(wv1, 0.f) & 0xffffu); }
        }
        const int ksmax = (16 * w + 15) >> 5;
        float el[4];
#pragma unroll
        for (int j = 0; j < 4; ++j) el[j] = __expf(cl[j]);
#pragma unroll
        for (int pt = 0; pt < 4; ++pt) {
            f32x4 yo = (f32x4){0.f, 0.f, 0.f, 0.f}, yd = (f32x4){0.f, 0.f, 0.f, 0.f};
#pragma unroll
            for (int ks = 0; ks < 4; ++ks) yo = mfma16(cfr[ks], *(const LAS bf16x8*)(lds + hcur + (16 * pt + fr) * RS + ks * 64 + fq * 16), yo);
#pragma unroll
            for (int ks = 0; ks < 4; ++ks) if (ks <= ksmax) yd = mfma16(*(const LAS bf16x8*)(lds + L_C + (16 * w + fr) * RS + ks * 64 + fq * 16), tr_frag(lds + xoff + ks * 32 * RSX + pt * 32, RSX), yd);
#pragma unroll
            for (int j = 0; j < 4; ++j) { const int lr = 16 * w + 4 * fq + j;
                *(LAS bf16_t*)(lds + L_Y + lr * RSY + (16 * pt + fr) * 2) = (bf16_t)(cvtpk(yd[j] + el[j] * yo[j], 0.f) & 0xffffu); }
        }
#pragma unroll
        for (int i = 0; i < 2; ++i) { const int lr = 16 * w + 8 * i + (lane >> 3), cx = lane & 7; const int row = r0 + (dir ? 127 - lr : lr);
            u32x4 yv = *(const LAS u32x4*)(lds + L_Y + lr * RSY + cx * 16);
            if (dir == 0) { float yf[8], xf[8]; unpack8(yv, yf); unpack8(*(const LAS u32x4*)(lds + L_X + lr * RSX + cx * 16), xf);
#pragma unroll
                for (int e2 = 0; e2 < 8; ++e2) yf[e2] += dskv * xf[e2];
                yv = pack8(yf); }
            *(u32x4*)(Y + (size_t)row * DIN + h * 64 + cx * 8) = yv; }
        bf16x8 btf[4];
#pragma unroll
        for (int ks = 0; ks < 4; ++ks) {
            const bf16x8 raw = tr_frag(lds + boff + ks * 32 * RS, RS);
            const f32x4 w0 = *(const LAS f32x4*)(wgS + ks * 32 + 8 * fq), w1 = *(const LAS f32x4*)(wgS + ks * 32 + 8 * fq + 4);
            u32x4 rw = __builtin_bit_cast(u32x4, raw);
            u32x4 o; o.x = cvtpk(bflo(rw.x) * w0.x, bfhi(rw.x) * w0.y); o.y = cvtpk(bflo(rw.y) * w0.z, bfhi(rw.y) * w0.w); o.z = cvtpk(bflo(rw.z) * w1.x, bfhi(rw.z) * w1.y); o.w = cvtpk(bflo(rw.w) * w1.z, bfhi(rw.w) * w1.w);
            btf[ks] = __builtin_bit_cast(bf16x8, o);
        }
        const float ed = __expf(cum_last);
#pragma unroll
        for (int pt = 0; pt < 4; ++pt) {
            hacc[pt] = hacc[pt] * ed;
#pragma unroll
            for (int ks = 0; ks < 4; ++ks) hacc[pt] = mfma16(tr_frag(lds + xoff + ks * 32 * RSX + pt * 32, RSX), btf[ks], hacc[pt]);
#pragma unroll
            for (int j = 0; j < 4; ++j) *(LAS bf16_t*)(lds + hnxt + (16 * pt + 4 * fq + j) * RS + (16 * w + fr) * 2) = (bf16_t)(cvtpk(hacc[pt][j], 0.f) & 0xffffu);
        }
        asm volatile("s_waitcnt lgkmcnt(0)" ::: "memory"); __builtin_amdgcn_s_barrier(); asm volatile("" ::: "memory");
    }
#undef SSD_LOAD
    if (!lat) { float* st = a.out + O_ST + ((((size_t)sb * DEPTH + l) * 2 + dir) * 32 + h) * 8192;
#pragma unroll
        for (int pt = 0; pt < 4; ++pt)
#pragma unroll
            for (int j = 0; j < 4; ++j) st[(16 * pt + 4 * fq + j) * 128 + 16 * w + fr] = hacc[pt][j]; }
}
}

__device__ __forceinline__ void mixer_phase(const Ctx& c, int l, int r) {
    CArgs& a = *c.a; unsigned* ctr = (unsigned*)(a.ws + WS_CTL) + 64 * l + 16 * r;
    LAS int* slot = (LAS int*)(c.lds + LDS_BYTES - 64);
    const bf16_t* Q = (const bf16_t*)(a.ws + WS_Q); const bf16_t* KB = (const bf16_t*)(a.ws + WS_K); const bf16_t* VB = (const bf16_t*)(a.ws + WS_V); bf16_t* AO = (bf16_t*)(a.ws + WS_AO);
    constexpr int N_SL = 128, N_AL = 256, N_SC = 1024, N_AC = 128, N_ALL = N_SL + N_AL + N_SC + N_AC;
    for (;;) {
        __syncthreads();
        if (c.tid == 0) *slot = (int)atomicAdd(ctr, 1u);
        __syncthreads();
        const int it = __builtin_amdgcn_readfirstlane(*slot);
        if (it >= N_ALL) break;
        const bool is_ssd = it < N_SL || (it >= N_SL + N_AL && it < N_SL + N_AL + N_SC);
        Ctx c2 = c; { const int t_ = fresh_tid(c.wid); c2.tid = t_; c2.lane = t_ & 63; }
        if (is_ssd) { sd::ssd_item(c2, l, it < N_SL ? it : it - N_AL); }
        else {
            size_t qrow, krow; int hq, seq;
            if (it < N_SL + N_AL) { const int u = it - N_SL, b = u >> 7, rem = u & 127, kvh = rem >> 6, r2 = rem & 63, qb = r2 >> 2; hq = kvh * 4 + (r2 & 3);
                qrow = (size_t)NCTX + b * 4096 + qb * 256; krow = (size_t)NCTX + b * LKV; seq = LKV; }
            else { const int u = it - N_SL - N_AL - N_SC, b = u >> 3; hq = u & 7; qrow = (size_t)b * 256; krow = qrow; seq = 256; }
            const int kvh = hq >> 2;
            at::attn_body(Q + qrow * DM + hq * 128, KB + krow * 256 + kvh * 128, VB + krow * 256 + kvh * 128, AO + qrow * DM + hq * 128, seq, c.ldsg, c2.tid);
        }
    }
}

__device__ __forceinline__ void ssd_gate_phase(const Ctx& c, int l) {
    CArgs& a = *c.a; bf16_t* YF = (bf16_t*)(a.ws + WS_YF); const bf16_t* YB = (const bf16_t*)(a.ws + WS_YB); const bf16_t* XB = (const bf16_t*)(a.ws + WS_XBC); const bf16_t* P = (const bf16_t*)(a.ws + WS_P);
    const float* nw = a.in[I_SSDN] + (size_t)l * DIN;
    for (int t = c.gw; t < T; t += c.ngw) {
        float y[4][8]; float ss = 0.f;
#pragma unroll
        for (int j = 0; j < 4; ++j) { const int col = j * 512 + c.lane * 8;
            float f[8], b[8], z[8];
            unpack8(*(const u32x4*)(YF + (size_t)t * DIN + col), f); unpack8(*(const u32x4*)(YB + (size_t)t * DIN + col), b);
            unpack8(*(const u32x4*)(P + (size_t)t * PW + PC_Z + col), z);
#pragma unroll
            for (int e = 0; e < 8; ++e) { const float v = (f[e] + b[e]) * siluf_(z[e]); y[j][e] = v; ss += v * v; } }
        const float rstd = rsqrtf(wave_sum(ss) * (1.f / DIN) + EPS);
#pragma unroll
        for (int j = 0; j < 4; ++j) { const int col = j * 512 + c.lane * 8; const f32x4 w0 = *(const f32x4*)(nw + col), w1 = *(const f32x4*)(nw + col + 4);
            float o[8] = {y[j][0] * rstd * w0.x, y[j][1] * rstd * w0.y, y[j][2] * rstd * w0.z, y[j][3] * rstd * w0.w, y[j][4] * rstd * w1.x, y[j][5] * rstd * w1.y, y[j][6] * rstd * w1.z, y[j][7] * rstd * w1.w};
            *(u32x4*)(YF + (size_t)t * DIN + col) = pack8(o); }
    }
}

__device__ __forceinline__ void ffn_act_phase(const Ctx& c, int l) {
    CArgs& a = *c.a; const bf16_t* U = (const bf16_t*)(a.ws + WS_P); bf16_t* ACT = (bf16_t*)(a.ws + WS_XBC);
    const float* fw = a.in[I_FCW] + (size_t)l * 3 * UPW; const float* fb = a.in[I_FCB] + (size_t)l * UPW;
    constexpr int NRUN = T / 32;
    for (int id = c.gw; id < NRUN * 6; id += c.ngw) {
        const int run = id / 6, wt = id % 6, t0 = run * 32; const int ci = wt * 64 + c.lane; if (ci >= DFF / 8) continue; const int c0 = ci * 8;
        const bool lat = t0 >= NCTX; const int tt = lat ? t0 - NCTX : t0; const int pos0 = lat ? tt & 4095 : tt & 255, L = lat ? 4096 : 256;
        float wv0[8], wv1[8], wv2[8], wg0[8], wg1[8], wg2[8], bv[8], bg[8];
#pragma unroll
        for (int e = 0; e < 8; ++e) { wv0[e] = fw[c0 + e]; wv1[e] = fw[UPW + c0 + e]; wv2[e] = fw[2 * UPW + c0 + e]; wg0[e] = fw[DFF + c0 + e]; wg1[e] = fw[UPW + DFF + c0 + e]; wg2[e] = fw[2 * UPW + DFF + c0 + e];
            bv[e] = fb[c0 + e]; bg[e] = fb[DFF + c0 + e]; }
        const bf16_t* base = U + (size_t)t0 * UPW + c0; bf16_t* ob = ACT + (size_t)t0 * DFF + c0;
        const u32x4 zz = zero4();
        const bool tail_ok = pos0 + 32 < L;
        u32x4 V[10], G[10], NV[8], NG[8];
        V[0] = zz; G[0] = zz; if (pos0 > 0) { V[0] = *(const u32x4*)(base - UPW); G[0] = *(const u32x4*)(base - UPW + DFF); }
        V[1] = *(const u32x4*)base; G[1] = *(const u32x4*)(base + DFF);
#pragma unroll
        for (int j = 0; j < 8; ++j) { V[2 + j] = *(const u32x4*)(base + (size_t)(1 + j) * UPW); G[2 + j] = *(const u32x4*)(base + (size_t)(1 + j) * UPW + DFF); }
        for (int blk = 0; blk < 4; ++blk) {
            const int i0 = blk * 8;
            if (blk < 3) {
#pragma unroll
                for (int j = 0; j < 8; ++j) { const int idx = i0 + 9 + j;
                    if (idx < 32 || tail_ok) { NV[j] = *(const u32x4*)(base + (size_t)idx * UPW); NG[j] = *(const u32x4*)(base + (size_t)idx * UPW + DFF); } else { NV[j] = zz; NG[j] = zz; } }
            }
#pragma unroll
            for (int j = 0; j < 8; ++j) {
                float xa[8], xb[8], xc[8], ya[8], yb[8], yc[8], o[8];
                unpack8(V[j], xa); unpack8(V[j + 1], xb); unpack8(V[j + 2], xc); unpack8(G[j], ya); unpack8(G[j + 1], yb); unpack8(G[j + 2], yc);
#pragma unroll
                for (int e = 0; e < 8; ++e) { const float uv = bv[e] + wv0[e] * xa[e] + wv1[e] * xb[e] + wv2[e] * xc[e]; const float ug = bg[e] + wg0[e] * ya[e] + wg1[e] * yb[e] + wg2[e] * yc[e]; o[e] = siluf_(ug) * uv; }
                *(u32x4*)(ob + (size_t)(i0 + j) * DFF) = pack8(o);
            }
            V[0] = V[8]; V[1] = V[9]; G[0] = G[8]; G[1] = G[9];
#pragma unroll
            for (int j = 0; j < 8; ++j) { V[2 + j] = NV[j]; G[2 + j] = NG[j]; }
        }
    }
}

namespace pg8 {
using gm::BM; using gm::BK; using gm::HALF; using gm::HTB; using gm::NXCD; using gm::WGM; using gm::lds_byte; using gm::stage_rc;
#define PG8_LAS LAS
__host__ __device__ __forceinline__ int perm32(int rho) { const int n = rho >> 4, i = rho & 15; return 8 * (i >> 2) + 4 * n + (i & 3); }
struct Unit { int pm, pn; };
struct Gemm { const bf16_t* A; const bf16_t* Bt; int M, N, K; };

struct StaticOrder {
    int nM, nN, nwg, G, c;
    __host__ __device__ void init(int M, int N, int G_, int c_, int bm = BM) { nM = M / bm; nN = N / BM; nwg = nM * nN; G = G_; c = c_; }
    __host__ __device__ bool next(int i, Unit& u) const {
        const long L = (long)i * G + c; if (L >= nwg) return false;
        int wgid = (int)L; { const int q = nwg / NXCD, r = nwg % NXCD, xcd = wgid % NXCD, off = wgid / NXCD; wgid = (xcd < r ? xcd * (q + 1) : r * (q + 1) + (xcd - r) * q) + off; }
        const int nig = WGM * nN, gid = wgid / nig, fm = gid * WGM, gsz = (nM - fm) < WGM ? (nM - fm) : WGM;
        u.pm = fm + ((wgid % nig) % gsz); u.pn = (wgid % nig) / gsz; return true;
    }
    __device__ __forceinline__ void a_ready(const Unit&) const {}
    __device__ __forceinline__ void done(const Unit&) const {}
};
template <class Epi, class Sched, bool ALIGN_EPI = false, bool SP2 = false, int MT = 4>
__device__ __forceinline__ void gemm_phase(PG8_LAS unsigned char* lds, const int tid, const Gemm g, const Sched& S, const Epi& E) {
    const int wid = __builtin_amdgcn_readfirstlane(tid >> 6), lane = tid & 63, wr = wid >> 2, wc = wid & 3, fr = lane & 15, fq = lane >> 4;
    const int K = g.K, nt = K / BK;
    unsigned voffA[2], voffB[2];
#pragma unroll
    for (int i = 0; i < 2; ++i) { int R, C; stage_rc(tid * 16 + i * 8192, R, C); const int Rb = Epi::PERM ? ((R & ~31) + perm32(R & 31)) : R;
        voffA[i] = (unsigned)(R * K + C) * 2u; voffB[i] = (unsigned)(Rb * K + C) * 2u; }
    const size_t kstep = (size_t)(BK * 2);
    const size_t hstepA = (size_t)(MT * 32) * K * 2, hstepB = (size_t)HALF * K * 2;
    const size_t tstepA = 2 * hstepA, tstepB = 2 * hstepB;
    const unsigned ldsw = (unsigned)wid * 1024u;
    const int aoff = lds_byte(wr * (MT * 16) + fr, fq * 8), boff = lds_byte(wc * 32 + fr, fq * 8);
#define PG8_SA(b, h) (((b) * 2 + (h)) * HTB)
#define PG8_SB(b, h) ((4 + (b) * 2 + (h)) * HTB)
#define PG8_STAGE(bufoff, gbase, voff) do { _Pragma("unroll") for (int _i = 0; _i < 2; ++_i) \
        __builtin_amdgcn_global_load_lds((const unsigned*)((const char*)(gbase) + (voff)[_i]), (PG8_LAS unsigned*)(lds + (bufoff) + ldsw + _i * 8192), 16, 0, 0); } while (0)
#define PG8_LDA(dst, b, h) do { _Pragma("unroll") for (int m = 0; m < MT; ++m) _Pragma("unroll") for (int k = 0; k < 2; ++k) dst[m][k] = *(const PG8_LAS bf16x8*)(lds + PG8_SA(b, h) + aoff + m * 2048 + k * 1024); } while (0)
#define PG8_LDB(dst, b, h) do { _Pragma("unroll") for (int n = 0; n < 2; ++n) _Pragma("unroll") for (int k = 0; k < 2; ++k) dst[n][k] = *(const PG8_LAS bf16x8*)(lds + PG8_SB(b, h) + boff + n * 2048 + k * 1024); } while (0)
#define PG8_MMA(ai, bj, At, Bt) do { __builtin_amdgcn_s_setprio(1); _Pragma("unroll") for (int m = 0; m < MT; ++m) _Pragma("unroll") for (int n = 0; n < 2; ++n) _Pragma("unroll") for (int k = 0; k < 2; ++k) \
        acc[ai][bj][m][n] = __builtin_amdgcn_mfma_f32_16x16x32_bf16(Bt[n][k], At[m][k], acc[ai][bj][m][n], 0, 0, 0); __builtin_amdgcn_s_setprio(0); } while (0)
#define PG8_WAIT_V(n) asm volatile("s_waitcnt vmcnt(" #n ")" ::: "memory")
#define PG8_WAIT_L(n) asm volatile("s_waitcnt lgkmcnt(" #n ")" ::: "memory")
#define PG8_BAR __builtin_amdgcn_s_barrier()
#define PG8_SCHED __builtin_amdgcn_sched_barrier(0)
    Unit cur, nxt; int ui = 0;
    if (!S.next(0, cur)) return;
    f32x4 acc[2][2][4][2];
#pragma unroll
    for (int a = 0; a < 2; ++a)
#pragma unroll
        for (int b = 0; b < 2; ++b)
#pragma unroll
            for (int m = 0; m < 4; ++m)
#pragma unroll
                for (int n = 0; n < 2; ++n) acc[a][b][m][n] = (f32x4){0.f, 0.f, 0.f, 0.f};
    bf16x8 At[4][2], B0[2][2], B1[2][2];
    const char* cA = (const char*)g.A + (size_t)cur.pm * tstepA; const char* cB = (const char*)g.Bt + (size_t)cur.pn * tstepB;
    S.a_ready(cur);
    if constexpr (SP2) {
        PG8_STAGE(PG8_SB(0, 0), cB, voffB); PG8_STAGE(PG8_SB(0, 1), cB + hstepB, voffB); PG8_STAGE(PG8_SA(0, 0), cA, voffA); PG8_STAGE(PG8_SA(0, 1), cA + hstepA, voffA);
        if (wr == 1) PG8_BAR;
        PG8_WAIT_V(2); PG8_BAR;
        PG8_STAGE(PG8_SB(1, 0), cB + kstep, voffB); PG8_STAGE(PG8_SA(1, 0), cA + kstep, voffA); PG8_STAGE(PG8_SB(1, 1), cB + hstepB + kstep, voffB);
        PG8_WAIT_V(6); PG8_BAR;
    } else {
        PG8_STAGE(PG8_SB(0, 0), cB, voffB); PG8_STAGE(PG8_SA(0, 0), cA, voffA); PG8_STAGE(PG8_SB(0, 1), cB + hstepB, voffB); PG8_STAGE(PG8_SA(0, 1), cA + hstepA, voffA);
        if (wr == 1) PG8_BAR;
        PG8_WAIT_V(4); PG8_BAR;
        PG8_STAGE(PG8_SB(1, 0), cB + kstep, voffB); PG8_STAGE(PG8_SA(1, 0), cA + kstep, voffA); PG8_STAGE(PG8_SB(1, 1), cB + hstepB + kstep, voffB);
        PG8_WAIT_V(6); PG8_BAR;
    }
    for (;;) {
        const bool has_next = S.next(ui + 1, nxt);
        const char* nA = has_next ? (const char*)g.A + (size_t)nxt.pm * tstepA : cA; const char* nB = has_next ? (const char*)g.Bt + (size_t)nxt.pn * tstepB : cB;
        for (int t = 0; t < nt; t += 2) {
            const bool last = (t == nt - 2);
            const char* a1 = cA + (size_t)(t + 1) * kstep;
            const char* a2 = last ? nA : cA + (size_t)(t + 2) * kstep; const char* b2 = last ? nB : cB + (size_t)(t + 2) * kstep;
            const char* a3 = a2 + kstep; const char* b3 = b2 + kstep;
            if (last && has_next) S.a_ready(nxt);
            if constexpr (SP2) {
            PG8_LDB(B0, 0, 0); PG8_LDB(B1, 0, 1); PG8_SCHED; PG8_LDA(At, 0, 0); PG8_STAGE(PG8_SA(1, 1), a1 + hstepA, voffA);
            PG8_WAIT_V(8); PG8_WAIT_L(0); PG8_BAR; PG8_MMA(0, 0, At, B0); PG8_MMA(0, 1, At, B1); PG8_BAR; PG8_SCHED;
            PG8_LDA(At, 0, 1); PG8_STAGE(PG8_SB(0, 0), b2, voffB); PG8_STAGE(PG8_SB(0, 1), b2 + hstepB, voffB); PG8_STAGE(PG8_SA(0, 0), a2, voffA);
            PG8_WAIT_V(8); PG8_WAIT_L(0); PG8_BAR; PG8_MMA(1, 0, At, B0); PG8_MMA(1, 1, At, B1); PG8_BAR; PG8_SCHED;
            PG8_LDB(B0, 1, 0); PG8_LDB(B1, 1, 1); PG8_SCHED; PG8_LDA(At, 1, 0); PG8_STAGE(PG8_SA(0, 1), a2 + hstepA, voffA);
            PG8_WAIT_V(8); PG8_WAIT_L(0); PG8_BAR; PG8_MMA(0, 0, At, B0); PG8_MMA(0, 1, At, B1); PG8_BAR; PG8_SCHED;
            PG8_LDA(At, 1, 1); PG8_STAGE(PG8_SB(1, 0), b3, voffB); PG8_STAGE(PG8_SB(1, 1), b3 + hstepB, voffB); PG8_STAGE(PG8_SA(1, 0), a3, voffA);
            PG8_WAIT_V(8); PG8_WAIT_L(0); PG8_BAR; PG8_MMA(1, 0, At, B0); PG8_MMA(1, 1, At, B1); PG8_BAR; PG8_SCHED;
            } else {
            PG8_LDB(B0, 0, 0); PG8_SCHED; PG8_LDA(At, 0, 0); PG8_STAGE(PG8_SA(1, 1), a1 + hstepA, voffA);
            PG8_WAIT_L(8); PG8_BAR; PG8_WAIT_L(0); PG8_MMA(0, 0, At, B0); PG8_BAR; PG8_SCHED;
            PG8_LDB(B1, 0, 1); PG8_STAGE(PG8_SB(0, 0), b2, voffB);
            PG8_BAR; PG8_WAIT_L(0); PG8_MMA(0, 1, At, B1); PG8_BAR;
            PG8_LDA(At, 0, 1); PG8_STAGE(PG8_SA(0, 0), a2, voffA);
            PG8_BAR; PG8_WAIT_L(0); PG8_MMA(1, 0, At, B0); PG8_BAR; PG8_SCHED;
            PG8_STAGE(PG8_SB(0, 1), b2 + hstepB, voffB);
            PG8_WAIT_V(6); PG8_BAR; PG8_MMA(1, 1, At, B1); PG8_BAR;
            PG8_LDB(B0, 1, 0); PG8_SCHED; PG8_LDA(At, 1, 0); PG8_STAGE(PG8_SA(0, 1), a2 + hstepA, voffA);
            PG8_WAIT_L(8); PG8_BAR; PG8_WAIT_L(0); PG8_MMA(0, 0, At, B0); PG8_BAR; PG8_SCHED;
            PG8_LDB(B1, 1, 1); PG8_STAGE(PG8_SB(1, 0), b3, voffB);
            PG8_BAR; PG8_WAIT_L(0); PG8_MMA(0, 1, At, B1); PG8_BAR;
            PG8_LDA(At, 1, 1); PG8_STAGE(PG8_SA(1, 0), a3, voffA);
            PG8_BAR; PG8_WAIT_L(0); PG8_MMA(1, 0, At, B0); PG8_BAR; PG8_SCHED;
            PG8_STAGE(PG8_SB(1, 1), b3 + hstepB, voffB);
            PG8_WAIT_V(6); PG8_BAR; PG8_MMA(1, 1, At, B1); PG8_BAR;
            }
        }
        if constexpr (ALIGN_EPI) { if (wr == 0) PG8_BAR; }
        if constexpr (!Epi::AFTER_DRAIN) { E(acc, cur, wr, wc, fr, fq); S.done(cur); }
        if (!has_next) break;
#pragma unroll
        for (int a = 0; a < 2; ++a)
#pragma unroll
            for (int b = 0; b < 2; ++b)
#pragma unroll
                for (int m = 0; m < 4; ++m)
#pragma unroll
                    for (int n = 0; n < 2; ++n) acc[a][b][m][n] = (f32x4){0.f, 0.f, 0.f, 0.f};
        cur = nxt; cA = nA; cB = nB; ++ui;
        if constexpr (ALIGN_EPI) { if (wr == 1) PG8_BAR; }
    }
    PG8_WAIT_V(0);
    if constexpr (!ALIGN_EPI) { if (wr == 0) PG8_BAR; }
    PG8_BAR;
    if constexpr (Epi::AFTER_DRAIN) { E.fused(acc, cur, wr, wc, fr, fq, lds, wid, lane); S.done(cur); }
#undef PG8_SA
#undef PG8_SB
#undef PG8_STAGE
#undef PG8_LDA
#undef PG8_LDB
#undef PG8_MMA
#undef PG8_WAIT_V
#undef PG8_WAIT_L
#undef PG8_BAR
#undef PG8_SCHED
}
}

struct EpiStoreBf16 {
    static constexpr bool PERM = true, AFTER_DRAIN = false;
    bf16_t* O; int ldc; float* DR; int dt_pn;
    __device__ __forceinline__ void operator()(const f32x4 (&acc)[2][2][4][2], const pg8::Unit& u, int wr, int wc, int fr, int fq) const {
        const int row0 = u.pm * 256 + wr * 64 + fr;
        if (u.pn != dt_pn) {
            const int col0 = u.pn * 256 + wc * 32 + 8 * fq;
#pragma unroll
            for (int ai = 0; ai < 2; ++ai)
#pragma unroll
                for (int m = 0; m < 4; ++m) { bf16_t* rowp = O + (size_t)(row0 + ai * 128 + m * 16) * ldc + col0;
#pragma unroll
                    for (int bj = 0; bj < 2; ++bj) { const f32x4 v0 = acc[ai][bj][m][0], v1 = acc[ai][bj][m][1];
                        u32x4 w; w.x = cvtpk(v0[0], v0[1]); w.y = cvtpk(v0[2], v0[3]); w.z = cvtpk(v1[0], v1[1]); w.w = cvtpk(v1[2], v1[3]);
                        *(u32x4*)(rowp + bj * 128) = w; } }
        } else if (wc < 2) {
#pragma unroll
            for (int ai = 0; ai < 2; ++ai)
#pragma unroll
                for (int m = 0; m < 4; ++m) { float* rp = DR + (size_t)(row0 + ai * 128 + m * 16) * 64 + wc * 32 + 8 * fq;
                    *(f32x4*)rp = acc[ai][0][m][0]; *(f32x4*)(rp + 4) = acc[ai][0][m][1]; }
        }
    }
};
template <bool SECOND, int MT> struct EpiGate {
    static constexpr bool PERM = true, AFTER_DRAIN = false;
    bf16_t* MG; const bf16_t* G;
    __device__ __forceinline__ void operator()(const f32x4 (&acc)[2][2][4][2], const pg8::Unit& u, int wr, int wc, int fr, int fq) const {
        const int row0 = u.pm * (64 * MT) + wr * (16 * MT) + fr, col0 = u.pn * 256 + wc * 32 + 8 * fq;
#pragma unroll
        for (int ai = 0; ai < 2; ++ai)
#pragma unroll
            for (int m = 0; m < MT; ++m) { const size_t row = (size_t)(row0 + ai * (32 * MT) + m * 16);
#pragma unroll
                for (int bj = 0; bj < 2; ++bj) { const int col = col0 + bj * 128;
                    float gv[8]; unpack8(*(const u32x4*)(G + row * PW + col), gv);
                    float t1[8] = {0.f, 0.f, 0.f, 0.f, 0.f, 0.f, 0.f, 0.f};
                    if (SECOND) unpack8(*(const u32x4*)(MG + row * DM + col), t1);
                    const f32x4 v0 = acc[ai][bj][m][0], v1 = acc[ai][bj][m][1];
                    float o[8];
#pragma unroll
                    for (int e = 0; e < 4; ++e) { o[e] = t1[e] + v0[e] * sigmoidf_(gv[e]); o[4 + e] = t1[4 + e] + v1[e] * sigmoidf_(gv[4 + e]); }
                    *(u32x4*)(MG + row * DM + col) = pack8(o); }
                asm volatile("" ::: "memory"); }
    }
};
template <int MT> struct EpiRes {
    static constexpr bool PERM = false, AFTER_DRAIN = false;
    float* X; const float* modl; bool fin;
    __device__ __forceinline__ void operator()(const f32x4 (&acc)[2][2][4][2], const pg8::Unit& u, int wr, int wc, int fr, int fq) const {
        const int row0 = u.pm * (64 * MT) + wr * (16 * MT) + fr, col0 = u.pn * 256 + wc * 32 + 4 * fq;
#pragma unroll
        for (int ai = 0; ai < 2; ++ai)
#pragma unroll
            for (int m = 0; m < MT; ++m) { const int row = row0 + ai * (32 * MT) + m * 16; float* xp = X + (size_t)row * DM + col0;
                const float* gp = modl + mod_idx(u.pm * (64 * MT) + wr * (16 * MT) + ai * (32 * MT) + m * 16) * 6144 + col0;
#pragma unroll
                for (int bj = 0; bj < 2; ++bj)
#pragma unroll
                    for (int n = 0; n < 2; ++n) { float* p = xp + bj * 128 + n * 16; const f32x4 gv = *(const f32x4*)(gp + bj * 128 + n * 16); if (fin) *(f32x4*)p = *(const f32x4*)p + gv * acc[ai][bj][m][n]; }
                asm volatile("" ::: "memory"); }
    }
};

__device__ __forceinline__ void g1_phase(const Ctx& c, int l) {
    CArgs& a = *c.a;
    pg8::Gemm g{(const bf16_t*)(a.ws + WS_H), (const bf16_t*)(a.ws + WS_W + (size_t)(l & 1) * WS_WSTRIDE) + W_IN, T, INWP, DM};
    pg8::StaticOrder S; S.init(T, INWP, (int)gridDim.x, (int)blockIdx.x);
    EpiStoreBf16 E{(bf16_t*)(a.ws + WS_P), PW, (float*)(a.ws + WS_DTR), INWP / 256 - 1};
    pg8::gemm_phase<EpiStoreBf16, pg8::StaticOrder, true, true>(c.lds, c.tid, g, S, E);
}
__device__ __forceinline__ void g2_phase(const Ctx& c, int l) {
    CArgs& a = *c.a; const bf16_t* W = (const bf16_t*)(a.ws + WS_W + (size_t)(l & 1) * WS_WSTRIDE); const bf16_t* P = (const bf16_t*)(a.ws + WS_P); bf16_t* MG = (bf16_t*)(a.ws + WS_H);
    if (blockIdx.x >= 192) {
        if (l + 1 < DEPTH) convert_weights(c, l + 1, (int)(blockIdx.x - 192) * 8 + c.wid, (int)(gridDim.x - 192) * 8);
        return;
    }
    pg8::StaticOrder S; S.init(T, 1024, (int)gridDim.x, (int)blockIdx.x);
    { pg8::Gemm g{(const bf16_t*)(a.ws + WS_AO), W + W_AO, T, 1024, 1024}; EpiGate<false, 4> E{MG, P + PC_GA};
      pg8::gemm_phase<EpiGate<false, 4>, pg8::StaticOrder, true, true, 4>(c.lds, c.tid, g, S, E); }
    const int t2 = fresh_tid(c.wid);
    { pg8::Gemm g{(const bf16_t*)(a.ws + WS_YF), W + W_SO, T, 1024, 2048}; EpiGate<true, 4> E{MG, P + PC_GS};
      pg8::gemm_phase<EpiGate<true, 4>, pg8::StaticOrder, true, true, 4>(c.lds, t2, g, S, E); }
}
__device__ __forceinline__ void gres_phase(const Ctx& c, int l, const bf16_t* A, int K, const bf16_t* W, int gate_off, bool fin) {
    CArgs& a = *c.a;
    pg8::Gemm g{A, W, T, 1024, K}; pg8::StaticOrder S; S.init(T, 1024, (int)gridDim.x, (int)blockIdx.x, 192);
    EpiRes<3> E{a.out + O_X, (const float*)(a.ws + WS_MOD) + (size_t)l * 3 * 6144 + gate_off, fin};
    pg8::gemm_phase<EpiRes<3>, pg8::StaticOrder, true, true, 3>(c.lds, c.tid, g, S, E);
}
__device__ __forceinline__ void g4_phase(const Ctx& c, int l) {
    CArgs& a = *c.a;
    pg8::Gemm g{(const bf16_t*)(a.ws + WS_H), (const bf16_t*)(a.ws + WS_W + (size_t)(l & 1) * WS_WSTRIDE) + W_UP, T, UPW, DM};
    pg8::StaticOrder S; S.init(T, UPW, (int)gridDim.x, (int)blockIdx.x);
    EpiStoreBf16 E{(bf16_t*)(a.ws + WS_P), UPW, nullptr, -1};
    pg8::gemm_phase<EpiStoreBf16, pg8::StaticOrder, true, true>(c.lds, c.tid, g, S, E);
}

#define XB_TMO      128
#define XB_XCNT(j)  (256  + 64 * (j))
#define XB_XSUB(j)  (1280 + 64 * (j))
#define XB_XGEN(j)  (2304 + 64 * (j))
#define XB_TOP      3328
#define XB_TOPGEN   3392
#define XCD_BAR_WORDS 3456
#define XB_SPIN_CAP (1u << 18)
__device__ __forceinline__ unsigned xb_ld(unsigned* p)              { return __hip_atomic_load(p, __ATOMIC_RELAXED, __HIP_MEMORY_SCOPE_AGENT); }
__device__ __forceinline__ unsigned xb_add(unsigned* p, unsigned v) { return __hip_atomic_fetch_add(p, v, __ATOMIC_RELAXED, __HIP_MEMORY_SCOPE_AGENT); }
__device__ __forceinline__ unsigned xb_xcc_id() { return (unsigned)__builtin_amdgcn_s_getreg((3 << 11) | 20) & 0xFu; }
#define XB_SPIN(cond, bar) do { unsigned _sp = 0; while (cond) { __builtin_amdgcn_s_sleep(1); \
    if ((++_sp & 255u) == 0u) { if (xb_ld(&(bar)[XB_TMO])) break; if (_sp > XB_SPIN_CAP) { atomicAdd(&(bar)[XB_TMO], 1u); break; } } } } while (0)
struct XcdBarrier { unsigned* bar; unsigned x; volatile LAS unsigned* st; };
__device__ __forceinline__ XcdBarrier xcd_barrier_post(unsigned* bar, volatile LAS unsigned* st) {
    XcdBarrier b; b.bar = bar; b.x = xb_xcc_id(); b.st = st;
    if (threadIdx.x == 0) (void)xb_add(&bar[XB_XCNT(b.x)], 1u);
    return b;
}
__device__ __forceinline__ void xcd_barrier_complete(unsigned* bar, unsigned x, unsigned& nloc, unsigned& nx) {
    const unsigned G = gridDim.x * gridDim.y * gridDim.z;
    unsigned sum, cnt, mine, sp = 0u;
    for (;;) {
        sum = 0u; cnt = 0u; mine = 0u;
#pragma unroll
        for (unsigned j = 0; j < 16; ++j) { const unsigned c = xb_ld(&bar[XB_XCNT(j)]); sum += c; cnt += (c > 0u) ? 1u : 0u; mine = (j == x) ? c : mine; }
        if (sum == G) break;
        __builtin_amdgcn_s_sleep(1);
        if ((++sp & 255u) == 0u) { if (xb_ld(&bar[XB_TMO])) break; if (sp > XB_SPIN_CAP) { atomicAdd(&bar[XB_TMO], 1u); break; } }
    }
    nloc = mine > 0u ? mine : 1u; nx = cnt > 0u ? cnt : 1u;
}
__device__ __forceinline__ void xcd_barrier(const XcdBarrier& b) {
    asm volatile("s_waitcnt vmcnt(0)" ::: "memory");
    __syncthreads();
    if (threadIdx.x == 0) {
        unsigned* bar = b.bar;
        __builtin_amdgcn_s_waitcnt(0);
        unsigned nloc = b.st[0], nx = b.st[1];
        if (nloc == 0u) { xcd_barrier_complete(bar, b.x, nloc, nx); b.st[0] = nloc; b.st[1] = nx; }
        const unsigned old = xb_add(&bar[XB_XSUB(b.x)], 1u);
        const unsigned gen = old / nloc;
        if (old + 1u == (gen + 1u) * nloc) {
            __builtin_amdgcn_fence(__ATOMIC_RELEASE, "agent");
            asm volatile("s_waitcnt vmcnt(0)" ::: "memory");
            const unsigned og = xb_add(&bar[XB_TOP], 1u);
            const unsigned tg = og / nx;
            if (og + 1u == (tg + 1u) * nx) xb_add(&bar[XB_TOPGEN], 1u);
            else XB_SPIN(xb_ld(&bar[XB_TOPGEN]) == tg, bar);
            __builtin_amdgcn_fence(__ATOMIC_ACQUIRE, "agent");
            xb_add(&bar[XB_XGEN(b.x)], 1u);
            asm volatile("s_waitcnt vmcnt(0)" ::: "memory");
        } else {
            XB_SPIN(xb_ld(&bar[XB_XGEN(b.x)]) == gen, bar);
            __builtin_amdgcn_fence(__ATOMIC_ACQUIRE, "agent");
            asm volatile("s_waitcnt vmcnt(0)" ::: "memory");
        }
    }
    __syncthreads();
}

__global__ void __launch_bounds__(512) mega(Args args) {
    extern __shared__ __attribute__((aligned(16))) unsigned char smem[];
    const int ph_lo = args.ph_lo, ph_hi = args.ph_hi, coop = args.coop;
    const int wid0 = __builtin_amdgcn_readfirstlane(threadIdx.x >> 6);
    volatile LAS unsigned* bst = (volatile LAS unsigned*)((LAS unsigned char*)smem + LDS_BYTES - 32);
    if (threadIdx.x < 2) bst[threadIdx.x] = 0u;
    __syncthreads();
    const XcdBarrier xbar = xcd_barrier_post((unsigned*)(args.ws + WS_CTL) + 4096, bst);
    if (ph_lo == 0) {
        Ctx c; c.a = (ArgsP)__builtin_amdgcn_kernarg_segment_ptr(); c.lds = (LAS unsigned char*)smem; c.ldsg = (char*)smem; c.tid = threadIdx.x; c.lane = c.tid & 63; c.wid = __builtin_amdgcn_readfirstlane(c.tid >> 6);
        c.gw = blockIdx.x * 8 + c.wid; c.ngw = gridDim.x * 8;
        setup_phase(c);
        if (1 < ph_hi) { if (coop == 2) cg::this_grid().sync(); else if (coop) xcd_barrier(xbar); }
        __syncthreads();
    }
    for (int ph = (ph_lo < 1 ? 1 : ph_lo); ph < ph_hi; ++ph) {
        const int l = (ph - 1) / NPH_LAYER, sp = (ph - 1) % NPH_LAYER;
        const int nrep = (REP_MASK != 0 && ((REP_MASK >> sp) & 1)) ? 2 : 1;
        for (int r = 0; r < nrep; ++r) {
            const bool fin = (r == nrep - 1);
            Ctx c; { ArgsP ap = (ArgsP)__builtin_amdgcn_kernarg_segment_ptr(); asm volatile("" : "+s"(ap)); c.a = ap; }
            c.lds = (LAS unsigned char*)smem; c.ldsg = (char*)smem;
            c.tid = fresh_tid(wid0);
            c.lane = c.tid & 63; c.wid = wid0;
            c.gw = blockIdx.x * 8 + c.wid; c.ngw = gridDim.x * 8;
            const bf16_t* Wl = (const bf16_t*)(c.a->ws + WS_W + (size_t)(l & 1) * WS_WSTRIDE);
            switch (sp) {
                case 0: if (l > 0 && gridDim.x <= 192) convert_weights(c, l, c.gw, c.ngw);
                        modulate_phase(c, l, 0); break;
                case 1: g1_phase(c, l); break;
                case 2: e2_phase(c, l); break;
                case 3: mixer_phase(c, l, r); break;
                case 4: ssd_gate_phase(c, l); break;
                case 5: g2_phase(c, l); break;
                case 6: gres_phase(c, l, (const bf16_t*)(c.a->ws + WS_H), 1024, Wl + W_OUT, 2048, fin); break;
                case 7: modulate_phase(c, l, 1); break;
                case 8: g4_phase(c, l); break;
                case 9: ffn_act_phase(c, l); break;
                default: gres_phase(c, l, (const bf16_t*)(c.a->ws + WS_XBC), DFF, Wl + W_DN, 5120, fin); break;
            }
            if (!fin) { if (coop) xcd_barrier(xbar); __syncthreads(); }
        }
#ifdef EXTRA_SYNC
        for (int es = 0; es < EXTRA_SYNC; ++es) { if (coop) xcd_barrier(xbar); }
#endif
        if (ph + 1 < ph_hi) { if (coop) xcd_barrier(xbar); }
        __syncthreads();
    }
}

extern "C" void kernel_launch(void* const* d_in, const int* in_sizes, int n_in, void* d_out, int out_size, void* d_ws, size_t ws_size, hipStream_t stream) {
    static int grid = 0;
    if (grid == 0) {
        if (n_in != 25 || ws_size < WS_END) { fprintf(stderr, "kernel_launch: unexpected n_in %d or ws_size %zu (< %zu)\n", n_in, ws_size, (size_t)WS_END); grid = -1; return; }
        if (hipFuncSetAttribute((const void*)mega, hipFuncAttributeMaxDynamicSharedMemorySize, LDS_BYTES) != hipSuccess) { fprintf(stderr, "kernel_launch: hipFuncSetAttribute failed\n"); grid = -1; return; }
        int dev = 0, cus = 0, per_cu = 0;
        hipGetDevice(&dev); hipDeviceGetAttribute(&cus, hipDeviceAttributeMultiprocessorCount, dev);
        hipOccupancyMaxActiveBlocksPerMultiprocessor(&per_cu, (const void*)mega, 512, LDS_BYTES);
        if (per_cu < 1) { fprintf(stderr, "kernel_launch: occupancy query says %d blocks/CU\n", per_cu); per_cu = 1; }
        (void)hipGetLastError();
        grid = cus * 1;
    }
    if (grid < 0) return;
    hipMemsetAsync((char*)d_ws + WS_CTL, 0, WS_ROPE, stream);
    Args a{};
    for (int i = 0; i < 25; ++i) a.in[i] = (const float*)d_in[i];
    a.out = (float*)d_out; a.ws = (unsigned char*)d_ws; a.pad = 0;
#if MK_MULTI
    for (int ph = 0; ph < NPH; ++ph) { a.ph_lo = ph; a.ph_hi = ph + 1; a.coop = 0; hipLaunchKernelGGL(mega, dim3(grid), dim3(512), LDS_BYTES, stream, a); }
#else
    a.ph_lo = 0; a.ph_hi = NPH; a.coop = 1;
    void* kargs[] = {&a};
    hipError_t e = hipLaunchCooperativeKernel((const void*)mega, dim3(grid), dim3(512), kargs, LDS_BYTES, stream);
    if (e != hipSuccess) fprintf(stderr, "cooperative launch failed: %s (grid %d)\n", hipGetErrorString(e), grid);
#endif
}
```

```cpp
#include <hip/hip_runtime.h>
#include <hip/hip_cooperative_groups.h>
#include <cstdint>
#include <cstdio>
namespace cg = cooperative_groups;

#ifndef MK_MULTI
#define MK_MULTI 0
#endif

#ifndef REP_MASK
#define REP_MASK 0
#endif
#define LAS __attribute__((address_space(3)))
typedef unsigned short bf16_t;
typedef short bf16x8 __attribute__((ext_vector_type(8)));
typedef short s16x4 __attribute__((ext_vector_type(4)));
typedef float f32x4 __attribute__((ext_vector_type(4)));
typedef float f32x16 __attribute__((ext_vector_type(16)));
typedef unsigned u32x4 __attribute__((ext_vector_type(4)));
typedef unsigned u32x2 __attribute__((ext_vector_type(2)));

constexpr int DM = 1024, NCTX = 16 * 256, NLAT = 2 * 4096, T = NCTX + NLAT;
constexpr int DEPTH = 4, PAST = 256, LKV = PAST + 4096;
constexpr int INW = 8768, PW = 8704, INWP = 8960;
constexpr int DFF = 2816, UPW = 5632, DIN = 2048, XBCW = 3072;
constexpr int PC_Q = 0, PC_K = 1024, PC_V = 1280, PC_Z = 1536, PC_XBC = 3584, PC_GA = 6656, PC_GS = 7680;
constexpr float EPS = 1e-6f;

constexpr size_t MiB = 1u << 20;
constexpr size_t WS_CTL = 0;
constexpr size_t WS_MOD = 1 * MiB;
constexpr size_t WS_ROPE = 1 * MiB + 512 * 1024;
constexpr size_t WS_W = 2 * MiB;
constexpr size_t W_IN = 0, W_AO = (size_t)INWP * 1024, W_SO = W_AO + 1024 * 1024, W_OUT = W_SO + 1024 * 2048, W_UP = W_OUT + 1024 * 1024, W_DN = W_UP + (size_t)UPW * 1024, W_END = W_DN + (size_t)1024 * DFF;
constexpr size_t WS_WSTRIDE = 43 * MiB;
constexpr size_t WS_P = 88 * MiB;
constexpr size_t WS_H = 294 * MiB;
constexpr size_t WS_Q = 318 * MiB;
constexpr size_t WS_AO = WS_Q;
constexpr size_t WS_K = 342 * MiB;
constexpr size_t WS_V = 349 * MiB;
constexpr size_t WS_XBC = 356 * MiB;
constexpr size_t WS_YF = 428 * MiB;
constexpr size_t WS_YB = 476 * MiB;
constexpr size_t WS_DTR = 524 * MiB;
constexpr size_t WS_DTV = 527 * MiB;
constexpr size_t WS_CUM = 530 * MiB;
constexpr size_t WS_END = 533 * MiB;
static_assert(WS_W + 2 * WS_WSTRIDE <= WS_P, "weight buffers");
static_assert(W_END * 2 <= WS_WSTRIDE, "weights");
constexpr size_t O_X = 0, O_CK = (size_t)T * DM, O_CV = O_CK + (size_t)16 * 4 * 256 * 256, O_ST = O_CV + (size_t)16 * 4 * 256 * 256;

constexpr int LDS_BYTES = 147456;
constexpr int NPH_LAYER = 11, NPH = 1 + DEPTH * NPH_LAYER;

struct Args { const float* in[25]; float* out; unsigned char* ws; int ph_lo, ph_hi, coop, pad; };
enum { I_XP = 0, I_XS, I_C, I_CK, I_CV, I_ST, I_CCTX, I_WMOD, I_BMOD, I_WIN, I_QN, I_KN, I_CONVW, I_CONVB, I_DTB, I_ALOG, I_DSKIP, I_SSDN, I_WAO, I_WSO, I_WOUT, I_WUP, I_FCW, I_FCB, I_WDN };

typedef float f32x2_t __attribute__((ext_vector_type(2))); typedef __bf16 bf16x2_t __attribute__((ext_vector_type(2)));
__device__ __forceinline__ unsigned cvtpk(float lo, float hi) { f32x2_t v = {lo, hi}; bf16x2_t b = __builtin_convertvector(v, bf16x2_t); return __builtin_bit_cast(unsigned, b); }
__device__ __forceinline__ float bf2f(unsigned short b) { return __uint_as_float((unsigned)b << 16); }
__device__ __forceinline__ float bflo(unsigned w) { return __uint_as_float(w << 16); }
__device__ __forceinline__ float bfhi(unsigned w) { return __uint_as_float(w & 0xffff0000u); }
__device__ __forceinline__ void unpack8(u32x4 w, float* f) { f[0] = bflo(w.x); f[1] = bfhi(w.x); f[2] = bflo(w.y); f[3] = bfhi(w.y); f[4] = bflo(w.z); f[5] = bfhi(w.z); f[6] = bflo(w.w); f[7] = bfhi(w.w); }
__device__ __forceinline__ u32x4 pack8(const float* f) { u32x4 w; w.x = cvtpk(f[0], f[1]); w.y = cvtpk(f[2], f[3]); w.z = cvtpk(f[4], f[5]); w.w = cvtpk(f[6], f[7]); return w; }
__device__ __forceinline__ u32x4 zero4() { u32x4 z = {0u, 0u, 0u, 0u}; asm volatile("" : "+v"(z)); return z; }
__device__ __forceinline__ float sigmoidf_(float x) { return __builtin_amdgcn_rcpf(1.f + __expf(-x)); }
__device__ __forceinline__ float siluf_(float x) { return x * __builtin_amdgcn_rcpf(1.f + __expf(-x)); }
__device__ __forceinline__ float wave_sum(float v) {
#pragma unroll
    for (int o = 1; o < 64; o <<= 1) v += __shfl_xor(v, o);
    return v;
}
__device__ __forceinline__ int fresh_tid(int wid) { int ln; asm volatile("v_mbcnt_lo_u32_b32 %0, -1, 0\n\tv_mbcnt_hi_u32_b32 %0, -1, %0" : "=v"(ln)); return wid * 64 + ln; }
__device__ __forceinline__ int mod_idx(int t) { return t < NCTX ? 0 : 1 + ((t - NCTX) >> 12); }

namespace gm {
constexpr int BM = 256, BK = 64, HALF = 128, HTB = HALF * BK * 2, NXCD = 8, WGM = 8;
__device__ __forceinline__ int lds_byte(int r, int c) { const int st = (r >> 4) * 2 + (c >> 5), rr = r & 15, cc = c & 31, ob = rr * 64 + cc * 2; return st * 1024 + (ob ^ (((ob >> 9) & 1) << 5)); }
__device__ __forceinline__ void stage_rc(int b, int& R, int& C) { const int st = b / 1024, sb = b % 1024, swz = sb ^ (((sb >> 9) & 1) << 5); R = (st >> 1) * 16 + swz / 64; C = (st & 1) * 32 + (swz % 64) / 2; }
__device__ __forceinline__ void tile_of(int L, int nM, int nN, int& pm, int& pn) {
    const int nwg = nM * nN; int wgid = L;
    { const int q = nwg / NXCD, r = nwg % NXCD, xcd = wgid % NXCD, off = wgid / NXCD; wgid = (xcd < r ? xcd * (q + 1) : r * (q + 1) + (xcd - r) * q) + off; }
    const int nig = WGM * nN, gid = wgid / nig, fm = gid * WGM, gsz = (nM - fm) < WGM ? (nM - fm) : WGM;
    pm = fm + ((wgid % nig) % gsz); pn = (wgid % nig) / gsz;
}
typedef f32x4 Acc[2][2][4][2];
__device__ __forceinline__ void zero_acc(Acc& acc) {
#pragma unroll
    for (int a = 0; a < 2; ++a)
#pragma unroll
        for (int b = 0; b < 2; ++b)
#pragma unroll
            for (int m = 0; m < 4; ++m)
#pragma unroll
                for (int n = 0; n < 2; ++n) acc[a][b][m][n] = (f32x4){0.f, 0.f, 0.f, 0.f};
}
__device__ __forceinline__ void kloop(LAS unsigned char* lds, int tid, const bf16_t* A, int lda, const bf16_t* Bt, int ldb, int K, Acc& acc) {
    const int wid = __builtin_amdgcn_readfirstlane(tid >> 6), lane = tid & 63, wr = wid >> 2, wc = wid & 3, fr = lane & 15, fq = lane >> 4;
    unsigned voffA[2], voffB[2];
#pragma unroll
    for (int i = 0; i < 2; ++i) { int R, C; stage_rc(tid * 16 + i * 8192, R, C); voffA[i] = (unsigned)(R * lda + C) * 2u; voffB[i] = (unsigned)(R * ldb + C) * 2u; }
    const char* cA = (const char*)A; const char* cB = (const char*)Bt;
    const size_t hA = (size_t)HALF * lda * 2, hB = (size_t)HALF * ldb * 2; const size_t ks = BK * 2;
    const unsigned ldsw = (unsigned)wid * 1024u;
    const int aoff = lds_byte(wr * 64 + fr, fq * 8), boff = lds_byte(wc * 32 + fr, fq * 8);
    const int nt = K / BK;
#define SA_(b, h) (((b) * 2 + (h)) * HTB)
#define SB_(b, h) ((4 + (b) * 2 + (h)) * HTB)
#define STAGE(bufoff, gbase, voff) do { _Pragma("unroll") for (int _i = 0; _i < 2; ++_i) \
        __builtin_amdgcn_global_load_lds((const unsigned*)((const char*)(gbase) + (voff)[_i]), (LAS unsigned*)(lds + (bufoff) + ldsw + _i * 8192), 16, 0, 0); } while (0)
#define LDA(dst, b, h) do { _Pragma("unroll") for (int m = 0; m < 4; ++m) _Pragma("unroll") for (int k = 0; k < 2; ++k) dst[m][k] = *(const LAS bf16x8*)(lds + SA_(b, h) + aoff + m * 2048 + k * 1024); } while (0)
#define LDB(dst, b, h) do { _Pragma("unroll") for (int n = 0; n < 2; ++n) _Pragma("unroll") for (int k = 0; k < 2; ++k) dst[n][k] = *(const LAS bf16x8*)(lds + SB_(b, h) + boff + n * 2048 + k * 1024); } while (0)
#define MMA(ai, bj, At, Bt_) do { __builtin_amdgcn_s_setprio(1); _Pragma("unroll") for (int m = 0; m < 4; ++m) _Pragma("unroll") for (int n = 0; n < 2; ++n) _Pragma("unroll") for (int k = 0; k < 2; ++k) \
        acc[ai][bj][m][n] = __builtin_amdgcn_mfma_f32_16x16x32_bf16(Bt_[n][k], At[m][k], acc[ai][bj][m][n], 0, 0, 0); __builtin_amdgcn_s_setprio(0); } while (0)
#define WAIT_V(n) asm volatile("s_waitcnt vmcnt(" #n ")" ::: "memory")
#define WAIT_L(n) asm volatile("s_waitcnt lgkmcnt(" #n ")" ::: "memory")
#define BAR __builtin_amdgcn_s_barrier()
#define SCHED __builtin_amdgcn_sched_barrier(0)
    bf16x8 At[4][2], B0[2][2], B1[2][2];
    STAGE(SB_(0, 0), cB, voffB); STAGE(SA_(0, 0), cA, voffA); STAGE(SB_(0, 1), cB + hB, voffB); STAGE(SA_(0, 1), cA + hA, voffA);
    if (wr == 1) BAR;
    WAIT_V(4); BAR;
    STAGE(SB_(1, 0), cB + ks, voffB); STAGE(SA_(1, 0), cA + ks, voffA); STAGE(SB_(1, 1), cB + hB + ks, voffB);
    WAIT_V(6); BAR;
    for (int t = 0; t < nt - 2; t += 2) {
        const char* a1 = cA + (size_t)(t + 1) * ks; const char* a2 = cA + (size_t)(t + 2) * ks; const char* b2 = cB + (size_t)(t + 2) * ks;
        const char* a3 = a2 + ks; const char* b3 = b2 + ks;
        LDB(B0, 0, 0); SCHED; LDA(At, 0, 0); STAGE(SA_(1, 1), a1 + hA, voffA);
        WAIT_L(8); BAR; WAIT_L(0); MMA(0, 0, At, B0); BAR; SCHED;
        LDB(B1, 0, 1); STAGE(SB_(0, 0), b2, voffB);
        BAR; WAIT_L(0); MMA(0, 1, At, B1); BAR;
        LDA(At, 0, 1); STAGE(SA_(0, 0), a2, voffA);
        BAR; WAIT_L(0); MMA(1, 0, At, B0); BAR; SCHED;
        STAGE(SB_(0, 1), b2 + hB, voffB);
        WAIT_V(6); BAR; MMA(1, 1, At, B1); BAR;
        LDB(B0, 1, 0); SCHED; LDA(At, 1, 0); STAGE(SA_(0, 1), a2 + hA, voffA);
        WAIT_L(8); BAR; WAIT_L(0); MMA(0, 0, At, B0); BAR; SCHED;
        LDB(B1, 1, 1); STAGE(SB_(1, 0), b3, voffB);
        BAR; WAIT_L(0); MMA(0, 1, At, B1); BAR;
        LDA(At, 1, 1); STAGE(SA_(1, 0), a3, voffA);
        BAR; WAIT_L(0); MMA(1, 0, At, B0); BAR; SCHED;
        STAGE(SB_(1, 1), b3 + hB, voffB);
        WAIT_V(6); BAR; MMA(1, 1, At, B1); BAR;
    }
    { const char* a1 = cA + (size_t)(nt - 1) * ks;
      LDB(B0, 0, 0); LDA(At, 0, 0); STAGE(SA_(1, 1), a1 + hA, voffA);
      BAR; WAIT_L(0); MMA(0, 0, At, B0); BAR;
      LDB(B1, 0, 1); BAR; WAIT_L(0); MMA(0, 1, At, B1); BAR;
      LDA(At, 0, 1); WAIT_V(4); BAR; WAIT_L(0); MMA(1, 0, At, B0); MMA(1, 1, At, B1); BAR; }
    { LDB(B0, 1, 0); LDA(At, 1, 0); WAIT_V(2); BAR; WAIT_L(0); MMA(0, 0, At, B0); BAR;
      LDB(B1, 1, 1); WAIT_V(0); BAR; WAIT_L(0); MMA(0, 1, At, B1); BAR;
      LDA(At, 1, 1); BAR; WAIT_L(0); MMA(1, 0, At, B0); MMA(1, 1, At, B1); BAR; }
    if (wr == 0) BAR;
#undef SA_
#undef SB_
#undef STAGE
#undef LDA
#undef LDB
#undef MMA
#undef WAIT_V
#undef WAIT_L
#undef BAR
#undef SCHED
}
template <class F> __device__ __forceinline__ void for_acc(Acc& acc, int tid, int brow, int bcol, F f) {
    const int wid = tid >> 6, lane = tid & 63, wr = wid >> 2, wc = wid & 3, fr = lane & 15, fq = lane >> 4;
#pragma unroll
    for (int ai = 0; ai < 2; ++ai)
#pragma unroll
        for (int m = 0; m < 4; ++m) {
            const int row = brow + ai * HALF + wr * 64 + m * 16 + fr;
#pragma unroll
            for (int bj = 0; bj < 2; ++bj)
#pragma unroll
                for (int n = 0; n < 2; ++n) f(row, bcol + bj * HALF + wc * 32 + n * 16 + fq * 4, acc[ai][bj][m][n]);
            asm volatile("" ::: "memory");
        }
}
}

namespace at {
constexpr int D = 128, NW = 8, QBLK = 32, KVBLK = 64;
constexpr float SCALE = 0.088388347648318440f, THR = 8.f;
constexpr int LDQ = 1024, LDK = 256, LDO = 1024;
constexpr int SHM_V = KVBLK * D * 2, SHM_K = KVBLK * D * 2, SHM_ATTN = 2 * SHM_V + 2 * SHM_K + NW * 64 * 4;
#define KSWZ(row, colB) ((row) * 256 + ((colB) ^ (((row) & 7) << 4)))
#define SBAR() __builtin_amdgcn_sched_barrier(0)
__device__ __forceinline__ int crow(int r, int hi) { return (r & 3) + 8 * (r >> 2) + 4 * hi; }
__device__ __forceinline__ void partialSM(f32x16& p0, f32x16& p1, float& m_reg, float& mn, float& alpha) {
    constexpr float C = SCALE * 1.4426950408889634f;
    float pmax = p0[0];
#pragma unroll
    for (int r = 1; r < 16; ++r) pmax = fmaxf(pmax, p0[r]);
#pragma unroll
    for (int r = 0; r < 16; ++r) pmax = fmaxf(pmax, p1[r]);
    { auto rr = __builtin_amdgcn_permlane32_swap(__float_as_uint(pmax), __float_as_uint(pmax), false, false);
      pmax = fmaxf(__uint_as_float(rr[0]), __uint_as_float(rr[1])); }
    if (__builtin_expect(__all(pmax - m_reg <= THR / SCALE), 1)) { mn = m_reg; alpha = 1.f; }
    else { mn = fmaxf(m_reg, pmax); alpha = __builtin_amdgcn_exp2f((m_reg - mn) * C); m_reg = mn; }
    float mnC = -mn * C;
#pragma unroll
    for (int r = 0; r < 16; ++r) p0[r] = fmaf(p0[r], C, mnC);
#pragma unroll
    for (int r = 0; r < 16; ++r) p1[r] = fmaf(p1[r], C, mnC);
#pragma unroll
    for (int r = 0; r < 16; ++r) p0[r] = __builtin_amdgcn_exp2f(p0[r]);
}
__device__ __forceinline__ void finishSM(f32x16& p0, f32x16& p1, float alpha, float& l_reg, bf16x8& pa0, bf16x8& pa1, bf16x8& pa2, bf16x8& pa3) {
#pragma unroll
    for (int r = 0; r < 16; ++r) p1[r] = __builtin_amdgcn_exp2f(p1[r]);
    float ps = 0;
#pragma unroll
    for (int r = 0; r < 16; ++r) ps += p0[r];
#pragma unroll
    for (int r = 0; r < 16; ++r) ps += p1[r];
    { auto rr = __builtin_amdgcn_permlane32_swap(__float_as_uint(ps), __float_as_uint(ps), false, false);
      ps = __uint_as_float(rr[0]) + __uint_as_float(rr[1]); }
    l_reg = l_reg * alpha + ps;
#define PK4(P, BASE, OUT) do { unsigned a0 = cvtpk(P[BASE + 0], P[BASE + 1]), a1 = cvtpk(P[BASE + 2], P[BASE + 3]);   \
    unsigned b0 = cvtpk(P[BASE + 4], P[BASE + 5]), b1 = cvtpk(P[BASE + 6], P[BASE + 7]);                              \
    auto r0 = __builtin_amdgcn_permlane32_swap(a0, b0, false, false); auto r1 = __builtin_amdgcn_permlane32_swap(a1, b1, false, false); \
    u32x4 w = {r0[0], r1[0], r0[1], r1[1]}; OUT = *reinterpret_cast<bf16x8*>(&w); } while (0)
    PK4(p0, 0, pa0); PK4(p0, 8, pa1); PK4(p1, 0, pa2); PK4(p1, 8, pa3);
#undef PK4
}
__device__ __forceinline__ void qkt(f32x16& p0, f32x16& p1, const bf16_t* Ks, const bf16x8* qr, int r32, int hi) {
    p0 = f32x16{}; p1 = f32x16{};
#pragma unroll
    for (int d0 = 0; d0 < 8; ++d0) { int cb = (d0 * 16 + hi * 8) * 2;
        bf16x8 b0 = *reinterpret_cast<const bf16x8*>((const char*)Ks + KSWZ(r32, cb));
        bf16x8 b1 = *reinterpret_cast<const bf16x8*>((const char*)Ks + KSWZ(32 + r32, cb));
        p0 = __builtin_amdgcn_mfma_f32_32x32x16_bf16(b0, qr[d0], p0, 0, 0, 0);
        p1 = __builtin_amdgcn_mfma_f32_32x32x16_bf16(b1, qr[d0], p1, 0, 0, 0); }
}
__device__ __forceinline__ int v_st(int k, int c) { const int kk = (k & ~0xC) | ((k & 4) << 1) | ((k & 8) >> 1); return ((kk >> 3) * 4 + (c >> 5)) * 512 + ((kk & 7) * 32 + (c & 31)) * 2; }
__device__ __forceinline__ int v_rd_base(int lane) { return ((lane & 3) << 3) | (((lane >> 2) & 3) << 6) | (((lane >> 4) & 1) << 5) | (((lane >> 5) & 1) << 8); }
constexpr int v_rd_off(int d0, int ks, int half) { return d0 * 512 + ks * 4096 + half * 2048; }
template <int OFF> __device__ __forceinline__ s16x4 tr_read(int vb) {
    s16x4 r; asm volatile("ds_read_b64_tr_b16 %0, %1 offset:%2" : "=&v"(r) : "v"(vb), "i"(OFF) : "memory"); return r;
}
template <int D0> __device__ __forceinline__ void pv_one(f32x16& od, int vb, bf16x8 pa0, bf16x8 pa1, bf16x8 pa2, bf16x8 pa3) {
    const s16x4 l0 = tr_read<v_rd_off(D0, 0, 0)>(vb), h0 = tr_read<v_rd_off(D0, 0, 1)>(vb), l1 = tr_read<v_rd_off(D0, 1, 0)>(vb), h1 = tr_read<v_rd_off(D0, 1, 1)>(vb);
    const s16x4 l2 = tr_read<v_rd_off(D0, 2, 0)>(vb), h2 = tr_read<v_rd_off(D0, 2, 1)>(vb), l3 = tr_read<v_rd_off(D0, 3, 0)>(vb), h3 = tr_read<v_rd_off(D0, 3, 1)>(vb);
    asm volatile("s_waitcnt lgkmcnt(0)" ::: "memory"); SBAR();
#define PK(L, H) (bf16x8){L[0], L[1], L[2], L[3], H[0], H[1], H[2], H[3]}
    od = __builtin_amdgcn_mfma_f32_32x32x16_bf16(pa0, PK(l0, h0), od, 0, 0, 0);
    od = __builtin_amdgcn_mfma_f32_32x32x16_bf16(pa1, PK(l1, h1), od, 0, 0, 0);
    od = __builtin_amdgcn_mfma_f32_32x32x16_bf16(pa2, PK(l2, h2), od, 0, 0, 0);
    od = __builtin_amdgcn_mfma_f32_32x32x16_bf16(pa3, PK(l3, h3), od, 0, 0, 0);
#undef PK
}
__device__ __forceinline__ void pv_d0(f32x16* o, int vb, bf16x8 pa0, bf16x8 pa1, bf16x8 pa2, bf16x8 pa3) {
    pv_one<0>(o[0], vb, pa0, pa1, pa2, pa3); pv_one<1>(o[1], vb, pa0, pa1, pa2, pa3); pv_one<2>(o[2], vb, pa0, pa1, pa2, pa3); pv_one<3>(o[3], vb, pa0, pa1, pa2, pa3);
}
__device__ __forceinline__ void attn_body(const bf16_t* __restrict__ Qb, const bf16_t* __restrict__ Kh, const bf16_t* __restrict__ Vh, bf16_t* __restrict__ Ob, int seq, char* lds, int tid) {
    const int wid = tid >> 6, lane = tid & 63, r32 = lane & 31, hi = lane >> 5;
    bf16_t* V_lds = (bf16_t*)lds; bf16_t* K_lds = (bf16_t*)(lds + 2 * SHM_V);
    float* ws = (float*)(lds + 2 * SHM_V + 2 * SHM_K) + wid * 64; float* li_l = ws; float* al_l = ws + 32;
    float m_reg = -1e30f, l_reg = 0; f32x16 o[4] = {}; bf16x8 qr[8];
    const bf16_t* Qw = Qb + (long)(wid * QBLK + r32) * LDQ + hi * 8;
#pragma unroll
    for (int d0 = 0; d0 < 8; ++d0) qr[d0] = *reinterpret_cast<const bf16x8*>(Qw + d0 * 16);
    const int sr = tid >> 4, sc = (tid & 15) * 8, vst0 = v_st(sr, sc), vst1 = v_st(32 + sr, sc);
    const int vb0 = (int)(uintptr_t)V_lds + v_rd_base(lane);
    struct { bf16x8 vs0, vs1, ks0, ks1; } sr_[2];
#define SLOAD(i, k0) do { sr_[i].vs0 = *(const bf16x8*)(&Vh[(long)((k0) + sr) * LDK + sc]); sr_[i].vs1 = *(const bf16x8*)(&Vh[(long)((k0) + 32 + sr) * LDK + sc]); \
    sr_[i].ks0 = *(const bf16x8*)(&Kh[(long)((k0) + sr) * LDK + sc]); sr_[i].ks1 = *(const bf16x8*)(&Kh[(long)((k0) + 32 + sr) * LDK + sc]); } while (0)
#define SWRITE(b, i) do { *(bf16x8*)((char*)V_lds + (b) * SHM_V + vst0) = sr_[i].vs0;          \
    *(bf16x8*)((char*)V_lds + (b) * SHM_V + vst1) = sr_[i].vs1; int kc = sc * 2;               \
    *(bf16x8*)((char*)K_lds + (b) * SHM_K + KSWZ(sr, kc)) = sr_[i].ks0;                       \
    *(bf16x8*)((char*)K_lds + (b) * SHM_K + KSWZ(32 + sr, kc)) = sr_[i].ks1; } while (0)
#define SWAIT() asm volatile("s_waitcnt vmcnt(4)" ::: "memory")
#define RESC(a) do { if (__any((a) < 1.f)) { if (hi == 0) al_l[r32] = (a); asm volatile("s_waitcnt lgkmcnt(0)" ::: "memory"); \
    _Pragma("unroll") for (int d = 0; d < 4; ++d) _Pragma("unroll") for (int r = 0; r < 16; ++r) o[d][r] *= al_l[crow(r, hi)]; } } while (0)
    f32x16 pA0, pA1, pB0, pB1; float mnA, mnB, alA, alB; bf16x8 pa0, pa1, pa2, pa3; const int NT = seq / KVBLK;
    constexpr int SE = 0, SO = 1;
    SLOAD(SE, 0); asm volatile("s_waitcnt vmcnt(0)" ::: "memory"); SWRITE(0, SE); __syncthreads();
    qkt(pA0, pA1, K_lds, qr, r32, hi); partialSM(pA0, pA1, m_reg, mnA, alA);
    SLOAD(SO, KVBLK); if (2 < NT) SLOAD(SE, 2 * KVBLK);
    SWAIT(); SWRITE(1, SO); __syncthreads();
    for (int j = 1; j + 1 < NT; j += 2) {
        SBAR(); qkt(pB0, pB1, (bf16_t*)((char*)K_lds + SHM_K), qr, r32, hi);
        finishSM(pA0, pA1, alA, l_reg, pa0, pa1, pa2, pa3); SBAR();
        SLOAD(SO, (j + 2) * KVBLK); SBAR();
        pv_d0(o, vb0, pa0, pa1, pa2, pa3); partialSM(pB0, pB1, m_reg, mnB, alB);
        __syncthreads(); SWAIT(); SWRITE(0, SE);
        RESC(alB); __syncthreads();
        SBAR(); qkt(pA0, pA1, K_lds, qr, r32, hi);
        finishSM(pB0, pB1, alB, l_reg, pa0, pa1, pa2, pa3); SBAR();
        if (j + 3 < NT) SLOAD(SE, (j + 3) * KVBLK); SBAR();
        pv_d0(o, vb0 + (int)SHM_V, pa0, pa1, pa2, pa3); partialSM(pA0, pA1, m_reg, mnA, alA);
        __syncthreads(); SWAIT(); SWRITE(1, SO);
        RESC(alA); __syncthreads();
    }
    SBAR(); qkt(pB0, pB1, (bf16_t*)((char*)K_lds + SHM_K), qr, r32, hi);
    finishSM(pA0, pA1, alA, l_reg, pa0, pa1, pa2, pa3); SBAR();
    pv_d0(o, vb0, pa0, pa1, pa2, pa3); partialSM(pB0, pB1, m_reg, mnB, alB);
    __syncthreads(); RESC(alB);
    finishSM(pB0, pB1, alB, l_reg, pa0, pa1, pa2, pa3); SBAR();
    pv_d0(o, vb0 + (int)SHM_V, pa0, pa1, pa2, pa3);
    if (hi == 0) li_l[r32] = l_reg; asm volatile("s_waitcnt lgkmcnt(0)" ::: "memory");
    float rli[16];
#pragma unroll
    for (int r = 0; r < 16; ++r) rli[r] = __builtin_amdgcn_rcpf(li_l[crow(r, hi)]);
    bf16_t* Ow = Ob + (long)(wid * QBLK) * LDO;
#pragma unroll
    for (int r = 0; r < 16; ++r) { int orow = crow(r, hi);
#pragma unroll
        for (int d0 = 0; d0 < 4; ++d0) Ow[(long)orow * LDO + d0 * 32 + r32] = (bf16_t)(cvtpk(o[d0][r] * rli[r], 0.f) & 0xffffu); }
    __syncthreads();
#undef SLOAD
#undef SWRITE
#undef SWAIT
#undef RESC
}
#undef KSWZ
#undef SBAR
}

typedef __attribute__((address_space(4))) const Args CArgs;
typedef CArgs* ArgsP;
struct Ctx {
    ArgsP a; LAS unsigned char* lds; char* ldsg; int tid, lane, wid, gw, ngw;
};

__device__ __forceinline__ unsigned f2bf(float f) { unsigned u = __float_as_uint(f); return (u + 0x7fffu + ((u >> 16) & 1u)) >> 16; }
__device__ __forceinline__ unsigned pk2(float lo, float hi) { return f2bf(lo) | (f2bf(hi) << 16); }
__device__ __forceinline__ void transpose_item(const float* W, int K, int N, bf16_t* WT, LAS float* scr, int item, int lane, bool remap) {
    const int nblk = N / 32, kb = item / nblk, nb = item % nblk, k0 = 64 * kb, n0 = 32 * nb;
    int r0 = n0;
    if (remap) r0 = (n0 < 6656) ? n0 : (n0 < 6720 ? n0 - 6656 + 8704 : n0 - 64);
    float tv[32];
#pragma unroll
    for (int i = 0; i < 32; ++i) { const int kk = 2 * i + (lane >> 5); tv[i] = __builtin_nontemporal_load(&W[(size_t)(k0 + kk) * N + n0 + (lane & 31)]); }
#pragma unroll
    for (int i = 0; i < 32; ++i) { const int kk = 2 * i + (lane >> 5); scr[kk * 33 + (lane & 31)] = tv[i]; }
    asm volatile("s_waitcnt lgkmcnt(0)" ::: "memory");
    const int c = lane & 7;
#pragma unroll
    for (int j = 0; j < 4; ++j) { const int n = (lane >> 3) + 8 * j; const LAS float* s = scr + (8 * c) * 33 + n;
        u32x4 o; o.x = pk2(s[0 * 33], s[1 * 33]); o.y = pk2(s[2 * 33], s[3 * 33]); o.z = pk2(s[4 * 33], s[5 * 33]); o.w = pk2(s[6 * 33], s[7 * 33]);
        *(u32x4*)(WT + (size_t)(r0 + n) * K + k0 + 8 * c) = o; }
    asm volatile("s_waitcnt lgkmcnt(0)" ::: "memory");
}
__device__ __forceinline__ void convert_weights(const Ctx& c, int l, int gw, int ngw) {
    CArgs& a = *c.a; bf16_t* W = (bf16_t*)(a.ws + WS_W + (size_t)(l & 1) * WS_WSTRIDE);
    LAS float* scr = (LAS float*)(c.lds + c.wid * 16384);
    constexpr int I_IN = 16 * (INW / 32), I_AO = 16 * 32, I_SO = 32 * 32, I_OUT = 16 * 32, I_UP = 16 * (UPW / 32), I_DN = (DFF / 64) * 32;
    constexpr int NIT = I_IN + I_AO + I_SO + I_OUT + I_UP + I_DN;
    for (int it = gw; it < NIT; it += ngw) {
        int r = it;
        if (r < I_IN) { transpose_item(a.in[I_WIN] + (size_t)l * 1024 * INW, 1024, INW, W + W_IN, scr, r, c.lane, true); continue; } r -= I_IN;
        if (r < I_AO) { transpose_item(a.in[I_WAO] + (size_t)l * 1024 * 1024, 1024, 1024, W + W_AO, scr, r, c.lane, false); continue; } r -= I_AO;
        if (r < I_SO) { transpose_item(a.in[I_WSO] + (size_t)l * 2048 * 1024, 2048, 1024, W + W_SO, scr, r, c.lane, false); continue; } r -= I_SO;
        if (r < I_OUT) { transpose_item(a.in[I_WOUT] + (size_t)l * 1024 * 1024, 1024, 1024, W + W_OUT, scr, r, c.lane, false); continue; } r -= I_OUT;
        if (r < I_UP) { transpose_item(a.in[I_WUP] + (size_t)l * 1024 * UPW, 1024, UPW, W + W_UP, scr, r, c.lane, false); continue; } r -= I_UP;
        transpose_item(a.in[I_WDN] + (size_t)l * DFF * 1024, DFF, 1024, W + W_DN, scr, r, c.lane, false);
    }
    for (int i = gw * 64 + c.lane; i < 192 * 1024 / 8; i += ngw * 64) *(u32x4*)(W + W_IN + (size_t)8768 * 1024 + (size_t)i * 8) = zero4();
}

__device__ __forceinline__ void modulate_phase(const Ctx& c, int l, int which) {
    CArgs& a = *c.a; const float* x = a.out + O_X; bf16_t* H = (bf16_t*)(a.ws + WS_H);
    const float* modl = (const float*)(a.ws + WS_MOD) + (size_t)l * 3 * 6144;
    for (int t = c.gw; t < T; t += c.ngw) {
        const float* md = modl + mod_idx(t) * 6144 + which * 3072; const float* sh = md; const float* sc = md + 1024;
        const f32x4* xr = (const f32x4*)(x + (size_t)t * DM);
        f32x4 v[4]; float s = 0.f;
#pragma unroll
        for (int j = 0; j < 4; ++j) { v[j] = xr[c.lane + 64 * j]; s += v[j].x * v[j].x + v[j].y * v[j].y + v[j].z * v[j].z + v[j].w * v[j].w; }
        const float rstd = rsqrtf(wave_sum(s) * (1.f / DM) + EPS);
#pragma unroll
        for (int j = 0; j < 4; ++j) { const int col = (c.lane + 64 * j) * 4; const f32x4 scv = *(const f32x4*)(sc + col), shv = *(const f32x4*)(sh + col);
            const f32x4 o = v[j] * rstd * (scv + 1.f) + shv; u32x2 w; w.x = cvtpk(o.x, o.y); w.y = cvtpk(o.z, o.w);
            *(u32x2*)(H + (size_t)t * DM + col) = w; }
    }
}

__device__ __forceinline__ void setup_phase(const Ctx& c) {
    CArgs& a = *c.a;
    { const int g = blockIdx.x * 512 + c.tid;
      if (g < 2048) { const int pos = g >> 5, i = g & 31; const float inv = __builtin_amdgcn_exp2f(-(float)i * (13.287712379549449f / 32.0f)); const float ang = (float)pos * inv;
          float* rt = (float*)(a.ws + WS_ROPE); rt[g] = __cosf(ang); rt[2048 + g] = __sinf(ang); } }
    LAS float* sl = (LAS float*)c.lds; LAS float* red = (LAS float*)(c.lds + 12288);
    for (int i = c.tid; i < 3072; i += 512) { const int s = i >> 10, k = i & 1023; const float cv = s == 0 ? a.in[I_CCTX][k] : a.in[I_C][(s - 1) * 1024 + k]; sl[i] = siluf_(cv); }
    __syncthreads();
    float* mod = (float*)(a.ws + WS_MOD);
    for (int item = blockIdx.x; item < 192; item += gridDim.x) {
        const int l = item / 48, cb = (item % 48) >> 1, kh = item & 1, col = cb * 256 + c.lane * 4, k0 = kh * 512 + c.wid * 64;
        f32x4 acc[3] = {{0.f, 0.f, 0.f, 0.f}, {0.f, 0.f, 0.f, 0.f}, {0.f, 0.f, 0.f, 0.f}};
        const float* wp = a.in[I_WMOD] + ((size_t)l * 1024 + k0) * 6144 + col;
#pragma unroll 16
        for (int k = 0; k < 64; ++k) { const f32x4 w = __builtin_nontemporal_load((const f32x4*)(wp + (size_t)k * 6144));
            acc[0] += w * sl[k0 + k]; acc[1] += w * sl[1024 + k0 + k]; acc[2] += w * sl[2048 + k0 + k]; }
#pragma unroll
        for (int s = 0; s < 3; ++s) *(LAS f32x4*)(red + (c.wid * 3 + s) * 256 + c.lane * 4) = acc[s];
        __syncthreads();
        for (int e = c.tid; e < 768; e += 512) { const int s = e >> 8, cc = e & 255; float v = kh == 0 ? a.in[I_BMOD][(size_t)l * 6144 + cb * 256 + cc] : 0.f;
#pragma unroll
            for (int w = 0; w < 8; ++w) v += red[(w * 3 + s) * 256 + cc];
            atomicAdd(&mod[((size_t)l * 3 + s) * 6144 + cb * 256 + cc], v); }
        __syncthreads();
    }
    { const f32x4* xp = (const f32x4*)a.in[I_XP]; const f32x4* xs = (const f32x4*)a.in[I_XS]; f32x4* o = (f32x4*)(a.out + O_X);
      const size_t n1 = (size_t)NCTX * DM / 4, n = (size_t)T * DM / 4, st = (size_t)gridDim.x * 512;
      for (size_t i = (size_t)blockIdx.x * 512 + c.tid; i < n; i += 4 * st) {
          f32x4 v[4];
#pragma unroll
          for (int u = 0; u < 4; ++u) { const size_t j = i + u * st; if (j < n) v[u] = j < n1 ? xp[j] : xs[j - n1]; }
#pragma unroll
          for (int u = 0; u < 4; ++u) { const size_t j = i + u * st; if (j < n) o[j] = v[u]; } } }
    convert_weights(c, 0, c.gw, c.ngw);
}

__device__ __forceinline__ void e2_phase(const Ctx& c, int l) {
    CArgs& a = *c.a;
    const bf16_t* P = (const bf16_t*)(a.ws + WS_P); bf16_t* Q = (bf16_t*)(a.ws + WS_Q); bf16_t* KB = (bf16_t*)(a.ws + WS_K); bf16_t* VB = (bf16_t*)(a.ws + WS_V);
    bf16_t* XB = (bf16_t*)(a.ws + WS_XBC);
    const float* rt = (const float*)(a.ws + WS_ROPE);
    const int lane = c.lane;
    constexpr int NT_DT = 96 * 16, NT_CACHE = 512, NRUN = T / 32, NT_TOK = NRUN * 9;
    for (int id = c.gw; id < NT_DT + NT_CACHE + NT_TOK; id += c.ngw) {
        if (id < NT_DT) {
            const int chk = id >> 4, col = (id & 15) * 4 + (lane >> 4), rg = lane & 15, dir = col >> 5, row0 = chk * 128;
            const float bias = a.in[I_DTB][l * 64 + col], av = -__expf(a.in[I_ALOG][l * 64 + col]);
            const float* dr = (const float*)(a.ws + WS_DTR); float* dv = (float*)(a.ws + WS_DTV); float* cm = (float*)(a.ws + WS_CUM);
            float d[8], cs[8];
#pragma unroll
            for (int e = 0; e < 8; ++e) { const int i = rg * 8 + e, row = row0 + (dir ? 127 - i : i); d[e] = dr[(size_t)row * 64 + col] + bias; }
            float run = 0.f;
#pragma unroll
            for (int e = 0; e < 8; ++e) { const float xr = d[e]; d[e] = xr > 20.f ? xr : log1pf(__expf(xr)); run += d[e] * av; cs[e] = run; }
            float inc = run;
#pragma unroll
            for (int o = 1; o < 16; o <<= 1) { const float t = __shfl_up(inc, o, 16); if (rg >= o) inc += t; }
            const float off = inc - run;
#pragma unroll
            for (int e = 0; e < 8; ++e) { const int i = rg * 8 + e, row = row0 + (dir ? 127 - i : i); dv[(size_t)row * 64 + col] = d[e]; cm[(size_t)row * 64 + col] = cs[e] + off; }
            continue;
        }
        if (id < NT_DT + NT_CACHE) {
            const int r = id - NT_DT, b = r >> 8, j = r & 255; const bool isv = lane >= 32; const int li = lane & 31;
            const float* src = a.in[isv ? I_CV : I_CK] + (((size_t)b * DEPTH + l) * PAST + j) * 256 + li * 8;
            const f32x4 v0 = *(const f32x4*)src, v1 = *(const f32x4*)(src + 4);
            u32x4 w; w.x = cvtpk(v0.x, v0.y); w.y = cvtpk(v0.z, v0.w); w.z = cvtpk(v1.x, v1.y); w.w = cvtpk(v1.z, v1.w);
            *(u32x4*)((isv ? VB : KB) + (size_t)(NCTX + b * LKV + j) * 256 + li * 8) = w;
            continue;
        }
        const int id2 = id - NT_DT - NT_CACHE;
        if (id2 < NRUN * 6) {
            const int run = id2 / 6, wt = id2 % 6, t0 = run * 32, c0 = (wt * 64 + lane) * 8;
            const bool lat = t0 >= NCTX; const int tt = lat ? t0 - NCTX : t0; const int pos0 = lat ? tt & 4095 : tt & 255, L = lat ? 4096 : 256;
            const float* cw = a.in[I_CONVW] + (size_t)l * 3 * XBCW + c0; const float* cbp = a.in[I_CONVB] + (size_t)l * XBCW + c0;
            float w0[8], w1[8], w2[8], bs[8];
#pragma unroll
            for (int e = 0; e < 8; ++e) { w0[e] = cw[e]; w1[e] = cw[XBCW + e]; w2[e] = cw[2 * XBCW + e]; bs[e] = cbp[e]; }
            const bf16_t* base = P + (size_t)t0 * PW + PC_XBC + c0; bf16_t* ob = XB + (size_t)t0 * XBCW + c0;
            const u32x4 zz = zero4();
            const bool tail_ok = pos0 + 32 < L;
            u32x4 R[10], N[8];
            R[0] = pos0 > 0 ? __builtin_nontemporal_load((const u32x4*)(base - PW)) : zz; R[1] = __builtin_nontemporal_load((const u32x4*)base);
#pragma unroll
            for (int j = 0; j < 8; ++j) R[2 + j] = __builtin_nontemporal_load((const u32x4*)(base + (size_t)(1 + j) * PW));
            for (int blk = 0; blk < 4; ++blk) {
                const int i0 = blk * 8;
                if (blk < 3) {
#pragma unroll
                    for (int j = 0; j < 8; ++j) { const int idx = i0 + 9 + j; N[j] = (idx < 32 || tail_ok) ? __builtin_nontemporal_load((const u32x4*)(base + (size_t)idx * PW)) : zz; }
                }
#pragma unroll
                for (int j = 0; j < 8; ++j) {
                    float xa[8], xb[8], xc[8], o[8]; unpack8(R[j], xa); unpack8(R[j + 1], xb); unpack8(R[j + 2], xc);
#pragma unroll
                    for (int e = 0; e < 8; ++e) o[e] = siluf_(bs[e] + w0[e] * xa[e] + w1[e] * xb[e] + w2[e] * xc[e]);
                    *(u32x4*)(ob + (size_t)(i0 + j) * XBCW) = pack8(o);
                }
                R[0] = R[8]; R[1] = R[9];
#pragma unroll
                for (int j = 0; j < 8; ++j) R[2 + j] = N[j];
            }
            continue;
        }
        const int id3 = id2 - NRUN * 6, run = id3 / 3, sub = id3 % 3, t0 = run * 32;
        const bool lat = t0 >= NCTX; const int tt0 = lat ? t0 - NCTX : t0; const int sb = lat ? tt0 >> 12 : tt0 >> 8, pos0 = lat ? tt0 & 4095 : tt0 & 255;
        const int li = lane & 15, d0 = li * 8; const int hq = sub * 4 + (lane >> 4);
        const bool isq = sub < 2, isv = !isq && lane >= 32; const int kvh = (lane >> 4) & 1;
        const int scol = isq ? PC_Q + hq * 128 + d0 : (isv ? PC_V : PC_K) + kvh * 128 + d0;
        float nwv[8];
        { const float* nw = a.in[isq ? I_QN : I_KN] + l * 128 + d0;
#pragma unroll
          for (int e = 0; e < 8; ++e) nwv[e] = nw[e]; }
        const bool first = (li & 7) < 4; const int fi = ((li & 3) * 8);
        const bf16_t* src0 = P + (size_t)t0 * PW + scol;
        for (int blk = 0; blk < 4; ++blk) {
        u32x4 RR[8];
#pragma unroll
        for (int j = 0; j < 8; ++j) RR[j] = __builtin_nontemporal_load((const u32x4*)(src0 + (size_t)(blk * 8 + j) * PW));
#pragma unroll
        for (int j = 0; j < 8; ++j) {
            const int i = blk * 8 + j; const u32x4 cur = RR[j];
            const int t = t0 + i, pos = pos0 + i;
            float xv[8]; unpack8(cur, xv);
            float ss = 0.f;
#pragma unroll
            for (int e = 0; e < 8; ++e) ss += xv[e] * xv[e];
            ss += __shfl_xor(ss, 1); ss += __shfl_xor(ss, 2); ss += __shfl_xor(ss, 4); ss += __shfl_xor(ss, 8);
            const float rstd = rsqrtf(ss * (1.f / 128.f) + EPS);
            float y[8];
#pragma unroll
            for (int e = 0; e < 8; ++e) y[e] = isv ? xv[e] : xv[e] * rstd * nwv[e];
            const int pr = pos >> 6, pc = pos & 63; const int pp = (li >> 3) ? pc : pr;
            const f32x4 cs0 = *(const f32x4*)(rt + pp * 32 + fi), cs1 = *(const f32x4*)(rt + pp * 32 + fi + 4), sn0 = *(const f32x4*)(rt + 2048 + pp * 32 + fi), sn1 = *(const f32x4*)(rt + 2048 + pp * 32 + fi + 4);
            const float csv[8] = {cs0.x, cs0.y, cs0.z, cs0.w, cs1.x, cs1.y, cs1.z, cs1.w}, snv[8] = {sn0.x, sn0.y, sn0.z, sn0.w, sn1.x, sn1.y, sn1.z, sn1.w};
            float o[8];
#pragma unroll
            for (int e = 0; e < 8; ++e) { const float xp = __shfl_xor(y[e], 4); const float r = y[e] * csv[e] + (first ? -xp : xp) * snv[e]; o[e] = (lat && !isv) ? r : y[e]; }
            const u32x4 w = pack8(o);
            if (isq) { *(u32x4*)(Q + (size_t)t * DM + hq * 128 + d0) = w; }
            else {
                const size_t krow = lat ? (size_t)(NCTX + sb * LKV + PAST + pos) : (size_t)t;
                *(u32x4*)((isv ? VB : KB) + krow * 256 + kvh * 128 + d0) = w;
                if (!lat) { float* dst = a.out + (isv ? O_CV : O_CK) + (((size_t)sb * DEPTH + l) * 256 + pos) * 256 + kvh * 128 + d0;
                    *(f32x4*)dst = (f32x4){o[0], o[1], o[2], o[3]}; *(f32x4*)(dst + 4) = (f32x4){o[4], o[5], o[6], o[7]}; }
            }
        }
        }
    }
}

namespace sd {
constexpr int RS = 272, RSX = 160;
constexpr int L_C = 0, L_B = 128 * RS, L_X = 2 * 128 * RS, L_H0 = L_X + 128 * RSX, L_H1 = L_H0 + 64 * RS, L_CUM = L_H1 + 64 * RS, L_DT = L_CUM + 512, L_WG = L_DT + 512, L_Y = L_WG + 512, RSY = 144, L_END = L_Y + 128 * RSY;
static_assert(L_END <= 144 * 1024 - 256, "ssd lds");
typedef short v4i16_t __attribute__((ext_vector_type(4)));
__device__ __forceinline__ f32x4 mfma16(bf16x8 a, bf16x8 b, f32x4 c) { return __builtin_amdgcn_mfma_f32_16x16x32_bf16(a, b, c, 0, 0, 0); }
__device__ __forceinline__ bf16x8 tr_frag(LAS unsigned char* p, int rs) {
    const v4i16_t lo = __builtin_amdgcn_ds_read_tr16_b64_v4i16((LAS v4i16_t*)p), hi = __builtin_amdgcn_ds_read_tr16_b64_v4i16((LAS v4i16_t*)(p + 4 * rs));
    return (bf16x8){lo[0], lo[1], lo[2], lo[3], hi[0], hi[1], hi[2], hi[3]};
}
__device__ __forceinline__ void ssd_item(const Ctx& c, int l, int item) {
    CArgs& a = *c.a; LAS unsigned char* lds = c.lds;
    const int tid = c.tid, lane = c.lane, w = c.wid, fr = lane & 15, fq = lane >> 4, tq = (lane & 15) >> 2, tp = lane & 3;
    int sb, dir, h, row_base, nc; bool lat;
    if (item < 128) { lat = true; sb = item >> 6; dir = (item >> 5) & 1; h = item & 31; row_base = NCTX + sb * 4096; nc = 32; }
    else { const int it = item - 128; lat = false; sb = it >> 6; dir = (it >> 5) & 1; h = it & 31; row_base = sb * 256; nc = 2; }
    const int g = h >> 3, dcol = dir * 32 + h; const float dskv = a.in[I_DSKIP][l * 32 + h];
    const bf16_t* XB = (const bf16_t*)(a.ws + WS_XBC); bf16_t* Y = (bf16_t*)(a.ws + (dir ? WS_YB : WS_YF));
    const float* dv = (const float*)(a.ws + WS_DTV); const float* cm = (const float*)(a.ws + WS_CUM);
    f32x4 hacc[4];
    if (lat) { const float* st = a.in[I_ST] + ((((size_t)sb * DEPTH + l) * 2 + dir) * 32 + h) * 8192;
#pragma unroll
        for (int pt = 0; pt < 4; ++pt)
#pragma unroll
            for (int j = 0; j < 4; ++j) hacc[pt][j] = st[(16 * pt + 4 * fq + j) * 128 + 16 * w + fr]; }
    else {
#pragma unroll
        for (int pt = 0; pt < 4; ++pt) hacc[pt] = (f32x4){0.f, 0.f, 0.f, 0.f}; }
#pragma unroll
    for (int pt = 0; pt < 4; ++pt)
#pragma unroll
        for (int j = 0; j < 4; ++j) *(LAS bf16_t*)(lds + L_H0 + (16 * pt + 4 * fq + j) * RS + (16 * w + fr) * 2) = (bf16_t)(cvtpk(hacc[pt][j], 0.f) & 0xffffu);
    LAS float* cumS = (LAS float*)(lds + L_CUM); LAS float* dtS = (LAS float*)(lds + L_DT); LAS float* wgS = (LAS float*)(lds + L_WG);
    const int ll = tid & 127;
    u32x4 pcv[4], pbv[4], pxv[2]; float pcmr, pdvr, pclast;
#define SSD_LOAD(cs_) do { const int ch_ = dir ? nc - 1 - (cs_) : (cs_); const int r0_ = row_base + ch_ * 128; \
        pclast = cm[(size_t)(r0_ + (dir ? 0 : 127)) * 64 + dcol]; \
        { const int row_ = r0_ + (dir ? 127 - ll : ll); pcmr = cm[(size_t)row_ * 64 + dcol]; pdvr = dv[(size_t)row_ * 64 + dcol]; } \
        _Pragma("unroll") for (int i = 0; i < 4; ++i) { const int q_ = tid + 512 * i, l_ = q_ >> 4, cx = q_ & 15; const bf16_t* xr_ = XB + (size_t)(r0_ + (dir ? 127 - l_ : l_)) * XBCW; \
            pcv[i] = *(const u32x4*)(xr_ + 2560 + g * 128 + cx * 8); pbv[i] = *(const u32x4*)(xr_ + 2048 + g * 128 + cx * 8); } \
        _Pragma("unroll") for (int i = 0; i < 2; ++i) { const int q_ = tid + 512 * i, l_ = q_ >> 3, cx = q_ & 7; const bf16_t* xr_ = XB + (size_t)(r0_ + (dir ? 127 - l_ : l_)) * XBCW; \
            pxv[i] = *(const u32x4*)(xr_ + h * 64 + cx * 8); } } while (0)
    SSD_LOAD(0);
    const int xoff = L_X + (8 * fq + tq) * RSX + 8 * tp, boff = L_B + (8 * fq + tq) * RS + (16 * w) * 2 + 8 * tp;
    for (int cs = 0; cs < nc; ++cs) {
        const int ch = dir ? nc - 1 - cs : cs; const int r0 = row_base + ch * 128;
        const int hcur = (cs & 1) ? L_H1 : L_H0, hnxt = (cs & 1) ? L_H0 : L_H1;
        const float cum_last = pclast;
        if (tid < 128) { cumS[ll] = pcmr; dtS[ll] = pdvr; wgS[ll] = __expf(cum_last - pcmr) * pdvr; }
#pragma unroll
        for (int i = 0; i < 4; ++i) { const int q_ = tid + 512 * i, l_ = q_ >> 4, cx = q_ & 15; *(LAS u32x4*)(lds + L_C + l_ * RS + cx * 16) = pcv[i]; *(LAS u32x4*)(lds + L_B + l_ * RS + cx * 16) = pbv[i]; }
#pragma unroll
        for (int i = 0; i < 2; ++i) { const int q_ = tid + 512 * i, l_ = q_ >> 3, cx = q_ & 7; *(LAS u32x4*)(lds + L_X + l_ * RSX + cx * 16) = pxv[i]; }
        if (cs + 1 < nc) SSD_LOAD(cs + 1);
        asm volatile("s_waitcnt lgkmcnt(0)" ::: "memory"); __builtin_amdgcn_s_barrier(); asm volatile("" ::: "memory");
        bf16x8 cfr[4];
#pragma unroll
        for (int ks = 0; ks < 4; ++ks) cfr[ks] = *(const LAS bf16x8*)(lds + L_C + (16 * w + fr) * RS + ks * 64 + fq * 16);
        float cl[4];
#pragma unroll
        for (int j = 0; j < 4; ++j) cl[j] = cumS[16 * w + 4 * fq + j];
        for (int ct = 0; ct <= w; ct += 2) {
            f32x4 cb0 = (f32x4){0.f, 0.f, 0.f, 0.f}, cb1 = (f32x4){0.f, 0.f, 0.f, 0.f};
#pragma unroll
            for (int ks = 0; ks < 4; ++ks) { cb0 = mfma16(cfr[ks], *(const LAS bf16x8*)(lds + L_B + (16 * ct + fr) * RS + ks * 64 + fq * 16), cb0);
                                             cb1 = mfma16(cfr[ks], *(const LAS bf16x8*)(lds + L_B + (16 * ct + 16 + fr) * RS + ks * 64 + fq * 16), cb1); }
            const int s0 = 16 * ct + fr, s1 = s0 + 16; const float csv0 = cumS[s0], dts0 = dtS[s0], csv1 = cumS[s1], dts1 = dtS[s1];
#pragma unroll
            for (int j = 0; j < 4; ++j) { const int lrow = 16 * w + 4 * fq + j;
                const float wv0 = (s0 <= lrow) ? cb0[j] * __expf(cl[j] - csv0) * dts0 : 0.f, wv1 = (s1 <= lrow) ? cb1[j] * __expf(cl[j] - csv1) * dts1 : 0.f;
                *(LAS bf16_t*)(lds + L_C + lrow * RS + s0 * 2) = (bf16_t)(cvtpk(wv0, 0.f) & 0xffffu); *(LAS bf16_t*)(lds + L_C + lrow * RS + s1 * 2) = (bf16_t)(cvtpk(wv1, 0.f) & 0xffffu); }
        }
        const int ksmax = (16 * w + 15) >> 5;
        float el[4];
#pragma unroll
        for (int j = 0; j < 4; ++j) el[j] = __expf(cl[j]);
#pragma unroll
        for (int pt = 0; pt < 4; ++pt) {
            f32x4 yo = (f32x4){0.f, 0.f, 0.f, 0.f}, yd = (f32x4){0.f, 0.f, 0.f, 0.f};
#pragma unroll
            for (int ks = 0; ks < 4; ++ks) yo = mfma16(cfr[ks], *(const LAS bf16x8*)(lds + hcur + (16 * pt + fr) * RS + ks * 64 + fq * 16), yo);
#pragma unroll
            for (int ks = 0; ks < 4; ++ks) if (ks <= ksmax) yd = mfma16(*(const LAS bf16x8*)(lds + L_C + (16 * w + fr) * RS + ks * 64 + fq * 16), tr_frag(lds + xoff + ks * 32 * RSX + pt * 32, RSX), yd);
#pragma unroll
            for (int j = 0; j < 4; ++j) { const int lr = 16 * w + 4 * fq + j;
                *(LAS bf16_t*)(lds + L_Y + lr * RSY + (16 * pt + fr) * 2) = (bf16_t)(cvtpk(yd[j] + el[j] * yo[j], 0.f) & 0xffffu); }
        }
#pragma unroll
        for (int i = 0; i < 2; ++i) { const int lr = 16 * w + 8 * i + (lane >> 3), cx = lane & 7; const int row = r0 + (dir ? 127 - lr : lr);
            u32x4 yv = *(const LAS u32x4*)(lds + L_Y + lr * RSY + cx * 16);
            if (dir == 0) { float yf[8], xf[8]; unpack8(yv, yf); unpack8(*(const LAS u32x4*)(lds + L_X + lr * RSX + cx * 16), xf);
#pragma unroll
                for (int e2 = 0; e2 < 8; ++e2) yf[e2] += dskv * xf[e2];
                yv = pack8(yf); }
            *(u32x4*)(Y + (size_t)row * DIN + h * 64 + cx * 8) = yv; }
        bf16x8 btf[4];
#pragma unroll
        for (int ks = 0; ks < 4; ++ks) {
            const bf16x8 raw = tr_frag(lds + boff + ks * 32 * RS, RS);
            const f32x4 w0 = *(const LAS f32x4*)(wgS + ks * 32 + 8 * fq), w1 = *(const LAS f32x4*)(wgS + ks * 32 + 8 * fq + 4);
            u32x4 rw = __builtin_bit_cast(u32x4, raw);
            u32x4 o; o.x = cvtpk(bflo(rw.x) * w0.x, bfhi(rw.x) * w0.y); o.y = cvtpk(bflo(rw.y) * w0.z, bfhi(rw.y) * w0.w); o.z = cvtpk(bflo(rw.z) * w1.x, bfhi(rw.z) * w1.y); o.w = cvtpk(bflo(rw.w) * w1.z, bfhi(rw.w) * w1.w);
            btf[ks] = __builtin_bit_cast(bf16x8, o);
        }
        const float ed = __expf(cum_last);
#pragma unroll
        for (int pt = 0; pt < 4; ++pt) {
            hacc[pt] = hacc[pt] * ed;
#pragma unroll
            for (int ks = 0; ks < 4; ++ks) hacc[pt] = mfma16(tr_frag(lds + xoff + ks * 32 * RSX + pt * 32, RSX), btf[ks], hacc[pt]);
#pragma unroll
            for (int j = 0; j < 4; ++j) *(LAS bf16_t*)(lds + hnxt + (16 * pt + 4 * fq + j) * RS + (16 * w + fr) * 2) = (bf16_t)(cvtpk(hacc[pt][j], 0.f) & 0xffffu);
        }
        asm volatile("s_waitcnt lgkmcnt(0)" ::: "memory"); __builtin_amdgcn_s_barrier(); asm volatile("" ::: "memory");
    }
#undef SSD_LOAD
    if (!lat) { float* st = a.out + O_ST + ((((size_t)sb * DEPTH + l) * 2 + dir) * 32 + h) * 8192;
#pragma unroll
        for (int pt = 0; pt < 4; ++pt)
#pragma unroll
            for (int j = 0; j < 4; ++j) st[(16 * pt + 4 * fq + j) * 128 + 16 * w + fr] = hacc[pt][j]; }
}
}

__device__ __forceinline__ void mixer_phase(const Ctx& c, int l, int r) {
    CArgs& a = *c.a; unsigned* ctr = (unsigned*)(a.ws + WS_CTL) + 64 * l + 16 * r;
    LAS int* slot = (LAS int*)(c.lds + LDS_BYTES - 64);
    const bf16_t* Q = (const bf16_t*)(a.ws + WS_Q); const bf16_t* KB = (const bf16_t*)(a.ws + WS_K); const bf16_t* VB = (const bf16_t*)(a.ws + WS_V); bf16_t* AO = (bf16_t*)(a.ws + WS_AO);
    constexpr int N_SL = 128, N_AL = 256, N_SC = 1024, N_AC = 128, N_ALL = N_SL + N_AL + N_SC + N_AC;
    for (;;) {
        __syncthreads();
        if (c.tid == 0) *slot = (int)atomicAdd(ctr, 1u);
        __syncthreads();
        const int it = __builtin_amdgcn_readfirstlane(*slot);
        if (it >= N_ALL) break;
        const bool is_ssd = it < N_SL || (it >= N_SL + N_AL && it < N_SL + N_AL + N_SC);
        Ctx c2 = c; { const int t_ = fresh_tid(c.wid); c2.tid = t_; c2.lane = t_ & 63; }
        if (is_ssd) { sd::ssd_item(c2, l, it < N_SL ? it : it - N_AL); }
        else {
            size_t qrow, krow; int hq, seq;
            if (it < N_SL + N_AL) { const int u = it - N_SL, b = u >> 7, rem = u & 127, kvh = rem >> 6, r2 = rem & 63, qb = r2 >> 2; hq = kvh * 4 + (r2 & 3);
                qrow = (size_t)NCTX + b * 4096 + qb * 256; krow = (size_t)NCTX + b * LKV; seq = LKV; }
            else { const int u = it - N_SL - N_AL - N_SC, b = u >> 3; hq = u & 7; qrow = (size_t)b * 256; krow = qrow; seq = 256; }
            const int kvh = hq >> 2;
            at::attn_body(Q + qrow * DM + hq * 128, KB + krow * 256 + kvh * 128, VB + krow * 256 + kvh * 128, AO + qrow * DM + hq * 128, seq, c.ldsg, c2.tid);
        }
    }
}

__device__ __forceinline__ void ssd_gate_phase(const Ctx& c, int l) {
    CArgs& a = *c.a; bf16_t* YF = (bf16_t*)(a.ws + WS_YF); const bf16_t* YB = (const bf16_t*)(a.ws + WS_YB); const bf16_t* XB = (const bf16_t*)(a.ws + WS_XBC); const bf16_t* P = (const bf16_t*)(a.ws + WS_P);
    const float* nw = a.in[I_SSDN] + (size_t)l * DIN;
    for (int t = c.gw; t < T; t += c.ngw) {
        float y[4][8]; float ss = 0.f;
#pragma unroll
        for (int j = 0; j < 4; ++j) { const int col = j * 512 + c.lane * 8;
            float f[8], b[8], z[8];
            unpack8(__builtin_nontemporal_load((const u32x4*)(YF + (size_t)t * DIN + col)), f); unpack8(__builtin_nontemporal_load((const u32x4*)(YB + (size_t)t * DIN + col)), b);
            unpack8(__builtin_nontemporal_load((const u32x4*)(P + (size_t)t * PW + PC_Z + col)), z);
#pragma unroll
            for (int e = 0; e < 8; ++e) { const float v = (f[e] + b[e]) * siluf_(z[e]); y[j][e] = v; ss += v * v; } }
        const float rstd = rsqrtf(wave_sum(ss) * (1.f / DIN) + EPS);
#pragma unroll
        for (int j = 0; j < 4; ++j) { const int col = j * 512 + c.lane * 8; const f32x4 w0 = *(const f32x4*)(nw + col), w1 = *(const f32x4*)(nw + col + 4);
            float o[8] = {y[j][0] * rstd * w0.x, y[j][1] * rstd * w0.y, y[j][2] * rstd * w0.z, y[j][3] * rstd * w0.w, y[j][4] * rstd * w1.x, y[j][5] * rstd * w1.y, y[j][6] * rstd * w1.z, y[j][7] * rstd * w1.w};
            *(u32x4*)(YF + (size_t)t * DIN + col) = pack8(o); }
    }
}

__device__ __forceinline__ void ffn_act_phase(const Ctx& c, int l) {
    CArgs& a = *c.a; const bf16_t* U = (const bf16_t*)(a.ws + WS_P); bf16_t* ACT = (bf16_t*)(a.ws + WS_XBC);
    const float* fw = a.in[I_FCW] + (size_t)l * 3 * UPW; const float* fb = a.in[I_FCB] + (size_t)l * UPW;
    constexpr int NRUN = T / 32;
    for (int id = c.gw; id < NRUN * 6; id += c.ngw) {
        const int run = id / 6, wt = id % 6, t0 = run * 32; const int ci = wt * 64 + c.lane; if (ci >= DFF / 8) continue; const int c0 = ci * 8;
        const bool lat = t0 >= NCTX; const int tt = lat ? t0 - NCTX : t0; const int pos0 = lat ? tt & 4095 : tt & 255, L = lat ? 4096 : 256;
        float wv0[8], wv1[8], wv2[8], wg0[8], wg1[8], wg2[8], bv[8], bg[8];
#pragma unroll
        for (int e = 0; e < 8; ++e) { wv0[e] = fw[c0 + e]; wv1[e] = fw[UPW + c0 + e]; wv2[e] = fw[2 * UPW + c0 + e]; wg0[e] = fw[DFF + c0 + e]; wg1[e] = fw[UPW + DFF + c0 + e]; wg2[e] = fw[2 * UPW + DFF + c0 + e];
            bv[e] = fb[c0 + e]; bg[e] = fb[DFF + c0 + e]; }
        const bf16_t* base = U + (size_t)t0 * UPW + c0; bf16_t* ob = ACT + (size_t)t0 * DFF + c0;
        const u32x4 zz = zero4();
        const bool tail_ok = pos0 + 32 < L;
        u32x4 V[10], G[10], NV[8], NG[8];
        V[0] = zz; G[0] = zz; if (pos0 > 0) { V[0] = __builtin_nontemporal_load((const u32x4*)(base - UPW)); G[0] = __builtin_nontemporal_load((const u32x4*)(base - UPW + DFF)); }
        V[1] = __builtin_nontemporal_load((const u32x4*)base); G[1] = __builtin_nontemporal_load((const u32x4*)(base + DFF));
#pragma unroll
        for (int j = 0; j < 8; ++j) { V[2 + j] = __builtin_nontemporal_load((const u32x4*)(base + (size_t)(1 + j) * UPW)); G[2 + j] = __builtin_nontemporal_load((const u32x4*)(base + (size_t)(1 + j) * UPW + DFF)); }
        for (int blk = 0; blk < 4; ++blk) {
            const int i0 = blk * 8;
            if (blk < 3) {
#pragma unroll
                for (int j = 0; j < 8; ++j) { const int idx = i0 + 9 + j;
                    if (idx < 32 || tail_ok) { NV[j] = __builtin_nontemporal_load((const u32x4*)(base + (size_t)idx * UPW)); NG[j] = __builtin_nontemporal_load((const u32x4*)(base + (size_t)idx * UPW + DFF)); } else { NV[j] = zz; NG[j] = zz; } }
            }
#pragma unroll
            for (int j = 0; j < 8; ++j) {
                float xa[8], xb[8], xc[8], ya[8], yb[8], yc[8], o[8];
                unpack8(V[j], xa); unpack8(V[j + 1], xb); unpack8(V[j + 2], xc); unpack8(G[j], ya); unpack8(G[j + 1], yb); unpack8(G[j + 2], yc);
#pragma unroll
                for (int e = 0; e < 8; ++e) { const float uv = bv[e] + wv0[e] * xa[e] + wv1[e] * xb[e] + wv2[e] * xc[e]; const float ug = bg[e] + wg0[e] * ya[e] + wg1[e] * yb[e] + wg2[e] * yc[e]; o[e] = siluf_(ug) * uv; }
                *(u32x4*)(ob + (size_t)(i0 + j) * DFF) = pack8(o);
            }
            V[0] = V[8]; V[1] = V[9]; G[0] = G[8]; G[1] = G[9];
#pragma unroll
            for (int j = 0; j < 8; ++j) { V[2 + j] = NV[j]; G[2 + j] = NG[j]; }
        }
    }
}

namespace pg8 {
using gm::BM; using gm::BK; using gm::HALF; using gm::HTB; using gm::NXCD; using gm::WGM; using gm::lds_byte; using gm::stage_rc;
#define PG8_LAS LAS
__host__ __device__ __forceinline__ int perm32(int rho) { const int n = rho >> 4, i = rho & 15; return 8 * (i >> 2) + 4 * n + (i & 3); }
struct Unit { int pm, pn; };
struct Gemm { const bf16_t* A; const bf16_t* Bt; int M, N, K; };

struct StaticOrder {
    int nM, nN, nwg, G, c;
    __host__ __device__ void init(int M, int N, int G_, int c_, int bm = BM) { nM = M / bm; nN = N / BM; nwg = nM * nN; G = G_; c = c_; }
    __host__ __device__ bool next(int i, Unit& u) const {
        const long L = (long)i * G + c; if (L >= nwg) return false;
        int wgid = (int)L; { const int q = nwg / NXCD, r = nwg % NXCD, xcd = wgid % NXCD, off = wgid / NXCD; wgid = (xcd < r ? xcd * (q + 1) : r * (q + 1) + (xcd - r) * q) + off; }
        const int nig = WGM * nN, gid = wgid / nig, fm = gid * WGM, gsz = (nM - fm) < WGM ? (nM - fm) : WGM;
        u.pm = fm + ((wgid % nig) % gsz); u.pn = (wgid % nig) / gsz; return true;
    }
    __device__ __forceinline__ void a_ready(const Unit&) const {}
    __device__ __forceinline__ void done(const Unit&) const {}
};
template <class Epi, class Sched, bool ALIGN_EPI = false, bool SP2 = false, int MT = 4>
__device__ __forceinline__ void gemm_phase(PG8_LAS unsigned char* lds, const int tid, const Gemm g, const Sched& S, const Epi& E) {
    const int wid = __builtin_amdgcn_readfirstlane(tid >> 6), lane = tid & 63, wr = wid >> 2, wc = wid & 3, fr = lane & 15, fq = lane >> 4;
    const int K = g.K, nt = K / BK;
    unsigned voffA[2], voffB[2];
#pragma unroll
    for (int i = 0; i < 2; ++i) { int R, C; stage_rc(tid * 16 + i * 8192, R, C); const int Rb = Epi::PERM ? ((R & ~31) + perm32(R & 31)) : R;
        voffA[i] = (unsigned)(R * K + C) * 2u; voffB[i] = (unsigned)(Rb * K + C) * 2u; }
    const size_t kstep = (size_t)(BK * 2);
    const size_t hstepA = (size_t)(MT * 32) * K * 2, hstepB = (size_t)HALF * K * 2;
    const size_t tstepA = 2 * hstepA, tstepB = 2 * hstepB;
    const unsigned ldsw = (unsigned)wid * 1024u;
    const int aoff = lds_byte(wr * (MT * 16) + fr, fq * 8), boff = lds_byte(wc * 32 + fr, fq * 8);
#define PG8_SA(b, h) (((b) * 2 + (h)) * HTB)
#define PG8_SB(b, h) ((4 + (b) * 2 + (h)) * HTB)
#define PG8_STAGE(bufoff, gbase, voff) do { _Pragma("unroll") for (int _i = 0; _i < 2; ++_i) \
        __builtin_amdgcn_global_load_lds((const unsigned*)((const char*)(gbase) + (voff)[_i]), (PG8_LAS unsigned*)(lds + (bufoff) + ldsw + _i * 8192), 16, 0, 0); } while (0)
#define PG8_LDA(dst, b, h) do { _Pragma("unroll") for (int m = 0; m < MT; ++m) _Pragma("unroll") for (int k = 0; k < 2; ++k) dst[m][k] = *(const PG8_LAS bf16x8*)(lds + PG8_SA(b, h) + aoff + m * 2048 + k * 1024); } while (0)
#define PG8_LDB(dst, b, h) do { _Pragma("unroll") for (int n = 0; n < 2; ++n) _Pragma("unroll") for (int k = 0; k < 2; ++k) dst[n][k] = *(const PG8_LAS bf16x8*)(lds + PG8_SB(b, h) + boff + n * 2048 + k * 1024); } while (0)
#define PG8_MMA(ai, bj, At, Bt) do { __builtin_amdgcn_s_setprio(1); _Pragma("unroll") for (int m = 0; m < MT; ++m) _Pragma("unroll") for (int n = 0; n < 2; ++n) _Pragma("unroll") for (int k = 0; k < 2; ++k) \
        acc[ai][bj][m][n] = __builtin_amdgcn_mfma_f32_16x16x32_bf16(Bt[n][k], At[m][k], acc[ai][bj][m][n], 0, 0, 0); __builtin_amdgcn_s_setprio(0); } while (0)
#define PG8_WAIT_V(n) asm volatile("s_waitcnt vmcnt(" #n ")" ::: "memory")
#define PG8_WAIT_L(n) asm volatile("s_waitcnt lgkmcnt(" #n ")" ::: "memory")
#define PG8_BAR __builtin_amdgcn_s_barrier()
#define PG8_SCHED __builtin_amdgcn_sched_barrier(0)
    Unit cur, nxt; int ui = 0;
    if (!S.next(0, cur)) return;
    f32x4 acc[2][2][4][2];
#pragma unroll
    for (int a = 0; a < 2; ++a)
#pragma unroll
        for (int b = 0; b < 2; ++b)
#pragma unroll
            for (int m = 0; m < 4; ++m)
#pragma unroll
                for (int n = 0; n < 2; ++n) acc[a][b][m][n] = (f32x4){0.f, 0.f, 0.f, 0.f};
    bf16x8 At[4][2], B0[2][2], B1[2][2];
    const char* cA = (const char*)g.A + (size_t)cur.pm * tstepA; const char* cB = (const char*)g.Bt + (size_t)cur.pn * tstepB;
    S.a_ready(cur);
    if constexpr (SP2) {
        PG8_STAGE(PG8_SB(0, 0), cB, voffB); PG8_STAGE(PG8_SB(0, 1), cB + hstepB, voffB); PG8_STAGE(PG8_SA(0, 0), cA, voffA); PG8_STAGE(PG8_SA(0, 1), cA + hstepA, voffA);
        if (wr == 1) PG8_BAR;
        PG8_WAIT_V(2); PG8_BAR;
        PG8_STAGE(PG8_SB(1, 0), cB + kstep, voffB); PG8_STAGE(PG8_SA(1, 0), cA + kstep, voffA); PG8_STAGE(PG8_SB(1, 1), cB + hstepB + kstep, voffB);
        PG8_WAIT_V(6); PG8_BAR;
    } else {
        PG8_STAGE(PG8_SB(0, 0), cB, voffB); PG8_STAGE(PG8_SA(0, 0), cA, voffA); PG8_STAGE(PG8_SB(0, 1), cB + hstepB, voffB); PG8_STAGE(PG8_SA(0, 1), cA + hstepA, voffA);
        if (wr == 1) PG8_BAR;
        PG8_WAIT_V(4); PG8_BAR;
        PG8_STAGE(PG8_SB(1, 0), cB + kstep, voffB); PG8_STAGE(PG8_SA(1, 0), cA + kstep, voffA); PG8_STAGE(PG8_SB(1, 1), cB + hstepB + kstep, voffB);
        PG8_WAIT_V(6); PG8_BAR;
    }
    for (;;) {
        const bool has_next = S.next(ui + 1, nxt);
        const char* nA = has_next ? (const char*)g.A + (size_t)nxt.pm * tstepA : cA; const char* nB = has_next ? (const char*)g.Bt + (size_t)nxt.pn * tstepB : cB;
        for (int t = 0; t < nt; t += 2) {
            const bool last = (t == nt - 2);
            const char* a1 = cA + (size_t)(t + 1) * kstep;
            const char* a2 = last ? nA : cA + (size_t)(t + 2) * kstep; const char* b2 = last ? nB : cB + (size_t)(t + 2) * kstep;
            const char* a3 = a2 + kstep; const char* b3 = b2 + kstep;
            if (last && has_next) S.a_ready(nxt);
            if constexpr (SP2) {
            PG8_LDB(B0, 0, 0); PG8_LDB(B1, 0, 1); PG8_SCHED; PG8_LDA(At, 0, 0); PG8_STAGE(PG8_SA(1, 1), a1 + hstepA, voffA);
            PG8_WAIT_V(8); PG8_WAIT_L(0); PG8_BAR; PG8_MMA(0, 0, At, B0); PG8_MMA(0, 1, At, B1); PG8_BAR; PG8_SCHED;
            PG8_LDA(At, 0, 1); PG8_STAGE(PG8_SB(0, 0), b2, voffB); PG8_STAGE(PG8_SB(0, 1), b2 + hstepB, voffB); PG8_STAGE(PG8_SA(0, 0), a2, voffA);
            PG8_WAIT_V(8); PG8_WAIT_L(0); PG8_BAR; PG8_MMA(1, 0, At, B0); PG8_MMA(1, 1, At, B1); PG8_BAR; PG8_SCHED;
            PG8_LDB(B0, 1, 0); PG8_LDB(B1, 1, 1); PG8_SCHED; PG8_LDA(At, 1, 0); PG8_STAGE(PG8_SA(0, 1), a2 + hstepA, voffA);
            PG8_WAIT_V(8); PG8_WAIT_L(0); PG8_BAR; PG8_MMA(0, 0, At, B0); PG8_MMA(0, 1, At, B1); PG8_BAR; PG8_SCHED;
            PG8_LDA(At, 1, 1); PG8_STAGE(PG8_SB(1, 0), b3, voffB); PG8_STAGE(PG8_SB(1, 1), b3 + hstepB, voffB); PG8_STAGE(PG8_SA(1, 0), a3, voffA);
            PG8_WAIT_V(8); PG8_WAIT_L(0); PG8_BAR; PG8_MMA(1, 0, At, B0); PG8_MMA(1, 1, At, B1); PG8_BAR; PG8_SCHED;
            } else {
            PG8_LDB(B0, 0, 0); PG8_SCHED; PG8_LDA(At, 0, 0); PG8_STAGE(PG8_SA(1, 1), a1 + hstepA, voffA);
            PG8_WAIT_L(8); PG8_BAR; PG8_WAIT_L(0); PG8_MMA(0, 0, At, B0); PG8_BAR; PG8_SCHED;
            PG8_LDB(B1, 0, 1); PG8_STAGE(PG8_SB(0, 0), b2, voffB);
            PG8_BAR; PG8_WAIT_L(0); PG8_MMA(0, 1, At, B1); PG8_BAR;
            PG8_LDA(At, 0, 1); PG8_STAGE(PG8_SA(0, 0), a2, voffA);
            PG8_BAR; PG8_WAIT_L(0); PG8_MMA(1, 0, At, B0); PG8_BAR; PG8_SCHED;
            PG8_STAGE(PG8_SB(0, 1), b2 + hstepB, voffB);
            PG8_WAIT_V(6); PG8_BAR; PG8_MMA(1, 1, At, B1); PG8_BAR;
            PG8_LDB(B0, 1, 0); PG8_SCHED; PG8_LDA(At, 1, 0); PG8_STAGE(PG8_SA(0, 1), a2 + hstepA, voffA);
            PG8_WAIT_L(8); PG8_BAR; PG8_WAIT_L(0); PG8_MMA(0, 0, At, B0); PG8_BAR; PG8_SCHED;
            PG8_LDB(B1, 1, 1); PG8_STAGE(PG8_SB(1, 0), b3, voffB);
            PG8_BAR; PG8_WAIT_L(0); PG8_MMA(0, 1, At, B1); PG8_BAR;
            PG8_LDA(At, 1, 1); PG8_STAGE(PG8_SA(1, 0), a3, voffA);
            PG8_BAR; PG8_WAIT_L(0); PG8_MMA(1, 0, At, B0); PG8_BAR; PG8_SCHED;
            PG8_STAGE(PG8_SB(1, 1), b3 + hstepB, voffB);
            PG8_WAIT_V(6); PG8_BAR; PG8_MMA(1, 1, At, B1); PG8_BAR;
            }
        }
        if constexpr (ALIGN_EPI) { if (wr == 0) PG8_BAR; }
        if constexpr (!Epi::AFTER_DRAIN) { E(acc, cur, wr, wc, fr, fq); S.done(cur); }
        if (!has_next) break;
#pragma unroll
        for (int a = 0; a < 2; ++a)
#pragma unroll
            for (int b = 0; b < 2; ++b)
#pragma unroll
                for (int m = 0; m < 4; ++m)
#pragma unroll
                    for (int n = 0; n < 2; ++n) acc[a][b][m][n] = (f32x4){0.f, 0.f, 0.f, 0.f};
        cur = nxt; cA = nA; cB = nB; ++ui;
        if constexpr (ALIGN_EPI) { if (wr == 1) PG8_BAR; }
    }
    PG8_WAIT_V(0);
    if constexpr (!ALIGN_EPI) { if (wr == 0) PG8_BAR; }
    PG8_BAR;
    if constexpr (Epi::AFTER_DRAIN) { E.fused(acc, cur, wr, wc, fr, fq, lds, wid, lane); S.done(cur); }
#undef PG8_SA
#undef PG8_SB
#undef PG8_STAGE
#undef PG8_LDA
#undef PG8_LDB
#undef PG8_MMA
#undef PG8_WAIT_V
#undef PG8_WAIT_L
#undef PG8_BAR
#undef PG8_SCHED
}
}

struct EpiStoreBf16 {
    static constexpr bool PERM = true, AFTER_DRAIN = false;
    bf16_t* O; int ldc; float* DR; int dt_pn;
    __device__ __forceinline__ void operator()(const f32x4 (&acc)[2][2][4][2], const pg8::Unit& u, int wr, int wc, int fr, int fq) const {
        const int row0 = u.pm * 256 + wr * 64 + fr;
        if (u.pn != dt_pn) {
            const int col0 = u.pn * 256 + wc * 32 + 8 * fq;
#pragma unroll
            for (int ai = 0; ai < 2; ++ai)
#pragma unroll
                for (int m = 0; m < 4; ++m) { bf16_t* rowp = O + (size_t)(row0 + ai * 128 + m * 16) * ldc + col0;
#pragma unroll
                    for (int bj = 0; bj < 2; ++bj) { const f32x4 v0 = acc[ai][bj][m][0], v1 = acc[ai][bj][m][1];
                        u32x4 w; w.x = cvtpk(v0[0], v0[1]); w.y = cvtpk(v0[2], v0[3]); w.z = cvtpk(v1[0], v1[1]); w.w = cvtpk(v1[2], v1[3]);
                        *(u32x4*)(rowp + bj * 128) = w; } }
        } else if (wc < 2) {
#pragma unroll
            for (int ai = 0; ai < 2; ++ai)
#pragma unroll
                for (int m = 0; m < 4; ++m) { float* rp = DR + (size_t)(row0 + ai * 128 + m * 16) * 64 + wc * 32 + 8 * fq;
                    *(f32x4*)rp = acc[ai][0][m][0]; *(f32x4*)(rp + 4) = acc[ai][0][m][1]; }
        }
    }
};
template <bool SECOND, int MT> struct EpiGate {
    static constexpr bool PERM = true, AFTER_DRAIN = false;
    bf16_t* MG; const bf16_t* G;
    __device__ __forceinline__ void operator()(const f32x4 (&acc)[2][2][4][2], const pg8::Unit& u, int wr, int wc, int fr, int fq) const {
        const int row0 = u.pm * (64 * MT) + wr * (16 * MT) + fr, col0 = u.pn * 256 + wc * 32 + 8 * fq;
#pragma unroll
        for (int ai = 0; ai < 2; ++ai)
#pragma unroll
            for (int m = 0; m < MT; ++m) { const size_t row = (size_t)(row0 + ai * (32 * MT) + m * 16);
#pragma unroll
                for (int bj = 0; bj < 2; ++bj) { const int col = col0 + bj * 128;
                    float gv[8]; unpack8(*(const u32x4*)(G + row * PW + col), gv);
                    float t1[8] = {0.f, 0.f, 0.f, 0.f, 0.f, 0.f, 0.f, 0.f};
                    if (SECOND) unpack8(*(const u32x4*)(MG + row * DM + col), t1);
                    const f32x4 v0 = acc[ai][bj][m][0], v1 = acc[ai][bj][m][1];
                    float o[8];
#pragma unroll
                    for (int e = 0; e < 4; ++e) { o[e] = t1[e] + v0[e] * sigmoidf_(gv[e]); o[4 + e] = t1[4 + e] + v1[e] * sigmoidf_(gv[4 + e]); }
                    *(u32x4*)(MG + row * DM + col) = pack8(o); }
                asm volatile("" ::: "memory"); }
    }
};
template <int MT> struct EpiRes {
    static constexpr bool PERM = false, AFTER_DRAIN = false;
    float* X; const float* modl; bool fin;
    __device__ __forceinline__ void operator()(const f32x4 (&acc)[2][2][4][2], const pg8::Unit& u, int wr, int wc, int fr, int fq) const {
        const int row0 = u.pm * (64 * MT) + wr * (16 * MT) + fr, col0 = u.pn * 256 + wc * 32 + 4 * fq;
#pragma unroll
        for (int ai = 0; ai < 2; ++ai)
#pragma unroll
            for (int m = 0; m < MT; ++m) { const int row = row0 + ai * (32 * MT) + m * 16; float* xp = X + (size_t)row * DM + col0;
                const float* gp = modl + mod_idx(u.pm * (64 * MT) + wr * (16 * MT) + ai * (32 * MT) + m * 16) * 6144 + col0;
#pragma unroll
                for (int bj = 0; bj < 2; ++bj)
#pragma unroll
                    for (int n = 0; n < 2; ++n) { float* p = xp + bj * 128 + n * 16; const f32x4 gv = *(const f32x4*)(gp + bj * 128 + n * 16); if (fin) *(f32x4*)p = *(const f32x4*)p + gv * acc[ai][bj][m][n]; }
                asm volatile("" ::: "memory"); }
    }
};

__device__ __forceinline__ void g1_phase(const Ctx& c, int l) {
    CArgs& a = *c.a;
    pg8::Gemm g{(const bf16_t*)(a.ws + WS_H), (const bf16_t*)(a.ws + WS_W + (size_t)(l & 1) * WS_WSTRIDE) + W_IN, T, INWP, DM};
    pg8::StaticOrder S; S.init(T, INWP, (int)gridDim.x, (int)blockIdx.x);
    EpiStoreBf16 E{(bf16_t*)(a.ws + WS_P), PW, (float*)(a.ws + WS_DTR), INWP / 256 - 1};
    pg8::gemm_phase<EpiStoreBf16, pg8::StaticOrder, true, true>(c.lds, c.tid, g, S, E);
}
__device__ __forceinline__ void g2_phase(const Ctx& c, int l) {
    CArgs& a = *c.a; const bf16_t* W = (const bf16_t*)(a.ws + WS_W + (size_t)(l & 1) * WS_WSTRIDE); const bf16_t* P = (const bf16_t*)(a.ws + WS_P); bf16_t* MG = (bf16_t*)(a.ws + WS_H);
    if (blockIdx.x >= 192) {
        if (l + 1 < DEPTH) convert_weights(c, l + 1, (int)(blockIdx.x - 192) * 8 + c.wid, (int)(gridDim.x - 192) * 8);
        return;
    }
    pg8::StaticOrder S; S.init(T, 1024, (int)gridDim.x, (int)blockIdx.x);
    { pg8::Gemm g{(const bf16_t*)(a.ws + WS_AO), W + W_AO, T, 1024, 1024}; EpiGate<false, 4> E{MG, P + PC_GA};
      pg8::gemm_phase<EpiGate<false, 4>, pg8::StaticOrder, true, true, 4>(c.lds, c.tid, g, S, E); }
    const int t2 = fresh_tid(c.wid);
    { pg8::Gemm g{(const bf16_t*)(a.ws + WS_YF), W + W_SO, T, 1024, 2048}; EpiGate<true, 4> E{MG, P + PC_GS};
      pg8::gemm_phase<EpiGate<true, 4>, pg8::StaticOrder, true, true, 4>(c.lds, t2, g, S, E); }
}
__device__ __forceinline__ void gres_phase(const Ctx& c, int l, const bf16_t* A, int K, const bf16_t* W, int gate_off, bool fin) {
    CArgs& a = *c.a;
    pg8::Gemm g{A, W, T, 1024, K}; pg8::StaticOrder S; S.init(T, 1024, (int)gridDim.x, (int)blockIdx.x, 192);
    EpiRes<3> E{a.out + O_X, (const float*)(a.ws + WS_MOD) + (size_t)l * 3 * 6144 + gate_off, fin};
    pg8::gemm_phase<EpiRes<3>, pg8::StaticOrder, true, true, 3>(c.lds, c.tid, g, S, E);
}
__device__ __forceinline__ void g4_phase(const Ctx& c, int l) {
    CArgs& a = *c.a;
    pg8::Gemm g{(const bf16_t*)(a.ws + WS_H), (const bf16_t*)(a.ws + WS_W + (size_t)(l & 1) * WS_WSTRIDE) + W_UP, T, UPW, DM};
    pg8::StaticOrder S; S.init(T, UPW, (int)gridDim.x, (int)blockIdx.x);
    EpiStoreBf16 E{(bf16_t*)(a.ws + WS_P), UPW, nullptr, -1};
    pg8::gemm_phase<EpiStoreBf16, pg8::StaticOrder, true, true>(c.lds, c.tid, g, S, E);
}

#define XB_TMO      128
#define XB_XCNT(j)  (256  + 64 * (j))
#define XB_XSUB(j)  (1280 + 64 * (j))
#define XB_XGEN(j)  (2304 + 64 * (j))
#define XB_TOP      3328
#define XB_TOPGEN   3392
#define XCD_BAR_WORDS 3456
#define XB_SPIN_CAP (1u << 18)
__device__ __forceinline__ unsigned xb_ld(unsigned* p)              { return __hip_atomic_load(p, __ATOMIC_RELAXED, __HIP_MEMORY_SCOPE_AGENT); }
__device__ __forceinline__ unsigned xb_add(unsigned* p, unsigned v) { return __hip_atomic_fetch_add(p, v, __ATOMIC_RELAXED, __HIP_MEMORY_SCOPE_AGENT); }
__device__ __forceinline__ unsigned xb_xcc_id() { return (unsigned)__builtin_amdgcn_s_getreg((3 << 11) | 20) & 0xFu; }
#define XB_SPIN(cond, bar) do { unsigned _sp = 0; while (cond) { __builtin_amdgcn_s_sleep(1); \
    if ((++_sp & 255u) == 0u) { if (xb_ld(&(bar)[XB_TMO])) break; if (_sp > XB_SPIN_CAP) { atomicAdd(&(bar)[XB_TMO], 1u); break; } } } } while (0)
struct XcdBarrier { unsigned* bar; unsigned x; volatile LAS unsigned* st; };
__device__ __forceinline__ XcdBarrier xcd_barrier_post(unsigned* bar, volatile LAS unsigned* st) {
    XcdBarrier b; b.bar = bar; b.x = xb_xcc_id(); b.st = st;
    if (threadIdx.x == 0) (void)xb_add(&bar[XB_XCNT(b.x)], 1u);
    return b;
}
__device__ __forceinline__ void xcd_barrier_complete(unsigned* bar, unsigned x, unsigned& nloc, unsigned& nx) {
    const unsigned G = gridDim.x * gridDim.y * gridDim.z;
    unsigned sum, cnt, mine, sp = 0u;
    for (;;) {
        sum = 0u; cnt = 0u; mine = 0u;
#pragma unroll
        for (unsigned j = 0; j < 16; ++j) { const unsigned c = xb_ld(&bar[XB_XCNT(j)]); sum += c; cnt += (c > 0u) ? 1u : 0u; mine = (j == x) ? c : mine; }
        if (sum == G) break;
        __builtin_amdgcn_s_sleep(1);
        if ((++sp & 255u) == 0u) { if (xb_ld(&bar[XB_TMO])) break; if (sp > XB_SPIN_CAP) { atomicAdd(&bar[XB_TMO], 1u); break; } }
    }
    nloc = mine > 0u ? mine : 1u; nx = cnt > 0u ? cnt : 1u;
}
__device__ __forceinline__ void xcd_barrier(const XcdBarrier& b) {
    asm volatile("s_waitcnt vmcnt(0)" ::: "memory");
    __syncthreads();
    if (threadIdx.x == 0) {
        unsigned* bar = b.bar;
        __builtin_amdgcn_s_waitcnt(0);
        unsigned nloc = b.st[0], nx = b.st[1];
        if (nloc == 0u) { xcd_barrier_complete(bar, b.x, nloc, nx); b.st[0] = nloc; b.st[1] = nx; }
        const unsigned old = xb_add(&bar[XB_XSUB(b.x)], 1u);
        const unsigned gen = old / nloc;
        if (old + 1u == (gen + 1u) * nloc) {
            __builtin_amdgcn_fence(__ATOMIC_RELEASE, "agent");
            asm volatile("s_waitcnt vmcnt(0)" ::: "memory");
            const unsigned og = xb_add(&bar[XB_TOP], 1u);
            const unsigned tg = og / nx;
            if (og + 1u == (tg + 1u) * nx) xb_add(&bar[XB_TOPGEN], 1u);
            else XB_SPIN(xb_ld(&bar[XB_TOPGEN]) == tg, bar);
            __builtin_amdgcn_fence(__ATOMIC_ACQUIRE, "agent");
            xb_add(&bar[XB_XGEN(b.x)], 1u);
            asm volatile("s_waitcnt vmcnt(0)" ::: "memory");
        } else {
            XB_SPIN(xb_ld(&bar[XB_XGEN(b.x)]) == gen, bar);
            __builtin_amdgcn_fence(__ATOMIC_ACQUIRE, "agent");
            asm volatile("s_waitcnt vmcnt(0)" ::: "memory");
        }
    }
    __syncthreads();
}

__global__ void __launch_bounds__(512) mega(Args args) {
    extern __shared__ __attribute__((aligned(16))) unsigned char smem[];
    const int ph_lo = args.ph_lo, ph_hi = args.ph_hi, coop = args.coop;
    const int wid0 = __builtin_amdgcn_readfirstlane(threadIdx.x >> 6);
    volatile LAS unsigned* bst = (volatile LAS unsigned*)((LAS unsigned char*)smem + LDS_BYTES - 32);
    if (threadIdx.x < 2) bst[threadIdx.x] = 0u;
    __syncthreads();
    const XcdBarrier xbar = xcd_barrier_post((unsigned*)(args.ws + WS_CTL) + 4096, bst);
    if (ph_lo == 0) {
        Ctx c; c.a = (ArgsP)__builtin_amdgcn_kernarg_segment_ptr(); c.lds = (LAS unsigned char*)smem; c.ldsg = (char*)smem; c.tid = threadIdx.x; c.lane = c.tid & 63; c.wid = __builtin_amdgcn_readfirstlane(c.tid >> 6);
        c.gw = blockIdx.x * 8 + c.wid; c.ngw = gridDim.x * 8;
        setup_phase(c);
        if (1 < ph_hi) { if (coop == 2) cg::this_grid().sync(); else if (coop) xcd_barrier(xbar); }
        __syncthreads();
    }
    for (int ph = (ph_lo < 1 ? 1 : ph_lo); ph < ph_hi; ++ph) {
        const int l = (ph - 1) / NPH_LAYER, sp = (ph - 1) % NPH_LAYER;
        const int nrep = (REP_MASK != 0 && ((REP_MASK >> sp) & 1)) ? 2 : 1;
        for (int r = 0; r < nrep; ++r) {
            const bool fin = (r == nrep - 1);
            Ctx c; { ArgsP ap = (ArgsP)__builtin_amdgcn_kernarg_segment_ptr(); asm volatile("" : "+s"(ap)); c.a = ap; }
            c.lds = (LAS unsigned char*)smem; c.ldsg = (char*)smem;
            c.tid = fresh_tid(wid0);
            c.lane = c.tid & 63; c.wid = wid0;
            c.gw = blockIdx.x * 8 + c.wid; c.ngw = gridDim.x * 8;
            const bf16_t* Wl = (const bf16_t*)(c.a->ws + WS_W + (size_t)(l & 1) * WS_WSTRIDE);
            switch (sp) {
                case 0: if (l > 0 && gridDim.x <= 192) convert_weights(c, l, c.gw, c.ngw);
                        modulate_phase(c, l, 0); break;
                case 1: g1_phase(c, l); break;
                case 2: e2_phase(c, l); break;
                case 3: mixer_phase(c, l, r); break;
                case 4: ssd_gate_phase(c, l); break;
                case 5: g2_phase(c, l); break;
                case 6: gres_phase(c, l, (const bf16_t*)(c.a->ws + WS_H), 1024, Wl + W_OUT, 2048, fin); break;
                case 7: modulate_phase(c, l, 1); break;
                case 8: g4_phase(c, l); break;
                case 9: ffn_act_phase(c, l); break;
                default: gres_phase(c, l, (const bf16_t*)(c.a->ws + WS_XBC), DFF, Wl + W_DN, 5120, fin); break;
            }
            if (!fin) { if (coop) xcd_barrier(xbar); __syncthreads(); }
        }
#ifdef EXTRA_SYNC
        for (int es = 0; es < EXTRA_SYNC; ++es) { if (coop) xcd_barrier(xbar); }
#endif
        if (ph + 1 < ph_hi) { if (coop) xcd_barrier(xbar); }
        __syncthreads();
    }
}

extern "C" void kernel_launch(void* const* d_in, const int* in_sizes, int n_in, void* d_out, int out_size, void* d_ws, size_t ws_size, hipStream_t stream) {
    static int grid = 0;
    if (grid == 0) {
        if (n_in != 25 || ws_size < WS_END) { fprintf(stderr, "kernel_launch: unexpected n_in %d or ws_size %zu (< %zu)\n", n_in, ws_size, (size_t)WS_END); grid = -1; return; }
        if (hipFuncSetAttribute((const void*)mega, hipFuncAttributeMaxDynamicSharedMemorySize, LDS_BYTES) != hipSuccess) { fprintf(stderr, "kernel_launch: hipFuncSetAttribute failed\n"); grid = -1; return; }
        int dev = 0, cus = 0, per_cu = 0;
        hipGetDevice(&dev); hipDeviceGetAttribute(&cus, hipDeviceAttributeMultiprocessorCount, dev);
        hipOccupancyMaxActiveBlocksPerMultiprocessor(&per_cu, (const void*)mega, 512, LDS_BYTES);
        if (per_cu < 1) { fprintf(stderr, "kernel_launch: occupancy query says %d blocks/CU\n", per_cu); per_cu = 1; }
        (void)hipGetLastError();
        grid = cus * 1;
    }
    if (grid < 0) return;
    hipMemsetAsync((char*)d_ws + WS_CTL, 0, WS_ROPE, stream);
    Args a{};
    for (int i = 0; i < 25; ++i) a.in[i] = (const float*)d_in[i];
    a.out = (float*)d_out; a.ws = (unsigned char*)d_ws; a.pad = 0;
#if MK_MULTI
    for (int ph = 0; ph < NPH; ++ph) { a.ph_lo = ph; a.ph_hi = ph + 1; a.coop = 0; hipLaunchKernelGGL(mega, dim3(grid), dim3(512), LDS_BYTES, stream, a); }
#else
    a.ph_lo = 0; a.ph_hi = NPH; a.coop = 1;
    void* kargs[] = {&a};
    hipError_t e = hipLaunchCooperativeKernel((const void*)mega, dim3(grid), dim3(512), kargs, LDS_BYTES, stream);
    if (e != hipSuccess) fprintf(stderr, "cooperative launch failed: %s (grid %d)\n", hipGetErrorString(e), grid);
#endif
}
```
